# Optimizing an MI355X kernel written in HIP

```python
import math
import jax, jax.numpy as jnp
from jax import lax
import numpy as np


D_MODEL = 1024
BATCH = 2
SEQ = 8192
DEPTH = 2

N_MIXERS = 2
N_POOL_LAYERS = (DEPTH + N_MIXERS - 1) // N_MIXERS
N_SSM_LAYERS = DEPTH // N_MIXERS
POOL_WINDOWS = (2, 4, 8, 16)
POOL_GROUPS = len(POOL_WINDOWS)
POOL_GROUP_DIM = D_MODEL // POOL_GROUPS
SSM_GROUP_DIM = 16
SSM_GROUPS = D_MODEL // SSM_GROUP_DIM
SSM_STATE = 64
N_DIRS = 2
D_FF = ((8 * D_MODEL) // 3 + 63) // 64 * 64
N_SUBLAYERS = 3
N_MOD = 3
EPS = 1e-6
DT_MIN = 1e-3
DT_MAX = 1e-1

kernel_name = 'hybrid_pool_s5_macaron_encoder'


def rms_norm(x, g):
    xf = x.astype(jnp.float32)
    y = xf * lax.rsqrt(jnp.mean(xf * xf, axis=-1, keepdims=True) + EPS)
    return (y * g.astype(jnp.float32)).astype(x.dtype)


def swiglu_ffn(h, w_in, w_out):
    gu = h @ w_in
    gate, up = jnp.split(gu, 2, axis=-1)
    return (jax.nn.silu(gate) * up) @ w_out


def centred_window_mean(u, window):
    S = u.shape[1]
    left = window // 2
    right = window - 1 - left
    csum = jnp.cumsum(u.astype(jnp.float32), axis=1)
    csum = jnp.pad(csum, ((0, 0), (1, 0), (0, 0)))
    t = jnp.arange(S, dtype=jnp.int32)
    lo = jnp.maximum(t - left, 0)
    hi = jnp.minimum(t + right, S - 1)
    total = jnp.take(csum, hi + 1, axis=1) - jnp.take(csum, lo, axis=1)
    count = (hi - lo + 1).astype(jnp.float32)
    return (total / count[None, :, None]).astype(u.dtype)


def pool_mixer(h, w_grp, b, scale):
    Bsz, S, D = h.shape
    hg = h.reshape(Bsz, S, POOL_GROUPS, POOL_GROUP_DIM)
    pooled = []
    for gi, window in enumerate(POOL_WINDOWS):
        ug = hg[:, :, gi]
        pooled.append(centred_window_mean(ug, window) - ug)
    p = jnp.stack(pooled, axis=2)
    y = jnp.einsum('bsgc,gcd->bsgd', p, w_grp).reshape(Bsz, S, D) + b
    return y * scale


def zoh_discretise(lam_re, lam_im, log_dt, b_re, b_im):
    dt = jnp.exp(log_dt)[:, None]
    mag = jnp.exp(lam_re * dt)
    ar = mag * jnp.cos(lam_im * dt)
    ai = mag * jnp.sin(lam_im * dt)
    den = lam_re * lam_re + lam_im * lam_im
    fr = ((ar - 1.0) * lam_re + ai * lam_im) / den
    fi = (ai * lam_re - (ar - 1.0) * lam_im) / den
    bb_re = fr[..., None] * b_re - fi[..., None] * b_im
    bb_im = fr[..., None] * b_im + fi[..., None] * b_re
    return ar, ai, bb_re, bb_im


def complex_linear_scan(a_re, a_im, bu_re, bu_im, reverse):
    S = bu_re.shape[1]
    a_re_s = jnp.broadcast_to(a_re, (1, S) + a_re.shape)
    a_im_s = jnp.broadcast_to(a_im, (1, S) + a_im.shape)

    def combine(e1, e2):
        ar1, ai1, br1, bi1 = e1
        ar2, ai2, br2, bi2 = e2
        ar = ar1 * ar2 - ai1 * ai2
        ai = ar1 * ai2 + ai1 * ar2
        br = ar2 * br1 - ai2 * bi1 + br2
        bi = ar2 * bi1 + ai2 * br1 + bi2
        return (ar, ai, br, bi)

    _, _, xr, xi = lax.associative_scan(combine, (a_re_s, a_im_s, bu_re, bu_im), reverse=reverse, axis=1)
    return xr, xi


def s5_mixer(h, lam_re, lam_im, log_dt, b_re, b_im, c_re, c_im, d_skip, w_glu, b_glu):
    Bsz, S, D = h.shape
    hf = h.astype(jnp.float32)
    u = hf.reshape(Bsz, S, SSM_GROUPS, SSM_GROUP_DIM)
    y = d_skip.astype(jnp.float32) * hf
    for direction in range(N_DIRS):
        ar, ai, bb_re, bb_im = zoh_discretise(
            lam_re[direction].astype(jnp.float32), lam_im[direction].astype(jnp.float32),
            log_dt[direction].astype(jnp.float32),
            b_re[direction].astype(jnp.float32), b_im[direction].astype(jnp.float32))
        bu_re = jnp.einsum('bsgh,gph->bsgp', u, bb_re)
        bu_im = jnp.einsum('bsgh,gph->bsgp', u, bb_im)
        xr, xi = complex_linear_scan(ar, ai, bu_re, bu_im, reverse=(direction == 1))
        yd = (jnp.einsum('bsgp,ghp->bsgh', xr, c_re[direction].astype(jnp.float32))
              - jnp.einsum('bsgp,ghp->bsgh', xi, c_im[direction].astype(jnp.float32)))
        y = y + yd.reshape(Bsz, S, D)
    y = jax.nn.gelu(y).astype(h.dtype)
    z = y @ w_glu + b_glu
    return z[..., :D] * jax.nn.sigmoid(z[..., D:])


def setup_inputs(seed: int = 0) -> dict:
    key = jax.random.key(seed)
    ks = jax.random.split(key, 24)
    D, G, P, H = D_MODEL, SSM_GROUPS, SSM_STATE, SSM_GROUP_DIM
    f32 = jnp.float32
    x = jax.random.normal(ks[0], (BATCH, SEQ, D), f32)
    c = jax.random.normal(ks[1], (BATCH, D), f32)
    mod_w = jax.random.normal(ks[2], (DEPTH, D, N_SUBLAYERS * N_MOD * D), f32) * (0.5 * D ** -0.5)
    mod_b = jax.random.normal(ks[3], (DEPTH, N_SUBLAYERS * N_MOD * D), f32) * 0.01
    norm_g = 1.0 + 0.05 * jax.random.normal(ks[4], (DEPTH, N_SUBLAYERS, D), f32)
    ffn_w_in = jax.random.normal(ks[5], (DEPTH, 2, D, 2 * D_FF), f32) * D ** -0.5
    ffn_w_out = jax.random.normal(ks[6], (DEPTH, 2, D_FF, D), f32) * D_FF ** -0.5
    pool_w = jax.random.normal(ks[7], (N_POOL_LAYERS, POOL_GROUPS, POOL_GROUP_DIM, POOL_GROUP_DIM), f32) * POOL_GROUP_DIM ** -0.5
    pool_b = jax.random.normal(ks[8], (N_POOL_LAYERS, D), f32) * 0.01
    pool_scale = 1.0 + 0.1 * jax.random.normal(ks[9], (N_POOL_LAYERS, D), f32)
    n_idx = jnp.arange(P, dtype=f32)
    ssm_lam_re = -0.5 + 0.01 * jax.random.normal(ks[10], (N_SSM_LAYERS, N_DIRS, G, P), f32)
    ssm_lam_im = math.pi * n_idx + 0.01 * jax.random.normal(ks[11], (N_SSM_LAYERS, N_DIRS, G, P), f32)
    ssm_log_dt = jax.random.uniform(ks[12], (N_SSM_LAYERS, N_DIRS, G), f32,
                                    minval=math.log(DT_MIN), maxval=math.log(DT_MAX))
    b_std = (2.0 * H) ** -0.5
    ssm_b_re = jax.random.normal(ks[13], (N_SSM_LAYERS, N_DIRS, G, P, H), f32) * b_std
    ssm_b_im = jax.random.normal(ks[14], (N_SSM_LAYERS, N_DIRS, G, P, H), f32) * b_std
    c_std = P ** -0.5
    ssm_c_re = jax.random.normal(ks[15], (N_SSM_LAYERS, N_DIRS, G, H, P), f32) * c_std
    ssm_c_im = jax.random.normal(ks[16], (N_SSM_LAYERS, N_DIRS, G, H, P), f32) * c_std
    ssm_d = jax.random.normal(ks[17], (N_SSM_LAYERS, D), f32)
    glu_w = jax.random.normal(ks[18], (N_SSM_LAYERS, D, 2 * D), f32) * D ** -0.5
    glu_b = jax.random.normal(ks[19], (N_SSM_LAYERS, 2 * D), f32) * 0.01
    final_g = 1.0 + 0.05 * jax.random.normal(ks[20], (D,), f32)
    return {'x': x, 'c': c, 'mod_w': mod_w, 'mod_b': mod_b, 'norm_g': norm_g,
            'ffn_w_in': ffn_w_in, 'ffn_w_out': ffn_w_out,
            'pool_w': pool_w, 'pool_b': pool_b, 'pool_scale': pool_scale,
            'ssm_lam_re': ssm_lam_re, 'ssm_lam_im': ssm_lam_im, 'ssm_log_dt': ssm_log_dt,
            'ssm_b_re': ssm_b_re, 'ssm_b_im': ssm_b_im, 'ssm_c_re': ssm_c_re, 'ssm_c_im': ssm_c_im,
            'ssm_d': ssm_d, 'glu_w': glu_w, 'glu_b': glu_b, 'final_g': final_g}


def reference(x, c, mod_w, mod_b, norm_g, ffn_w_in, ffn_w_out, pool_w, pool_b, pool_scale,
              ssm_lam_re, ssm_lam_im, ssm_log_dt, ssm_b_re, ssm_b_im, ssm_c_re, ssm_c_im,
              ssm_d, glu_w, glu_b, final_g):
    Bsz, S, D = x.shape
    cond = jax.nn.silu(c)
    for i in range(DEPTH):
        mod = (cond @ mod_w[i] + mod_b[i]).reshape(Bsz, N_SUBLAYERS, N_MOD, D)
        shift = mod[:, :, 0][:, :, None, :]
        scale = mod[:, :, 1][:, :, None, :]
        gate = mod[:, :, 2][:, :, None, :]

        h = rms_norm(x, norm_g[i, 0]) * (1.0 + scale[:, 0]) + shift[:, 0]
        x = x + 0.5 * gate[:, 0] * swiglu_ffn(h, ffn_w_in[i, 0], ffn_w_out[i, 0])

        h = rms_norm(x, norm_g[i, 1]) * (1.0 + scale[:, 1]) + shift[:, 1]
        j = i // N_MIXERS
        if i % N_MIXERS == 0:
            m = pool_mixer(h, pool_w[j], pool_b[j], pool_scale[j])
        else:
            m = s5_mixer(h, ssm_lam_re[j], ssm_lam_im[j], ssm_log_dt[j], ssm_b_re[j], ssm_b_im[j],
                         ssm_c_re[j], ssm_c_im[j], ssm_d[j], glu_w[j], glu_b[j])
        x = x + gate[:, 1] * m

        h = rms_norm(x, norm_g[i, 2]) * (1.0 + scale[:, 2]) + shift[:, 2]
        x = x + 0.5 * gate[:, 2] * swiglu_ffn(h, ffn_w_in[i, 1], ffn_w_out[i, 1])
    return rms_norm(x, final_g)
```

```cpp
#include <hip/hip_runtime.h>
#include <hip/hip_cooperative_groups.h>
#include <cstdio>
#include <cstdint>
namespace cg = cooperative_groups;

#ifndef ONE_LAUNCH
#define ONE_LAUNCH 1
#endif
#ifndef DUP_PH
#define DUP_PH -1
#endif
#ifndef DUP_HI
#define DUP_HI 13
#endif
#define DUP_LEN (DUP_PH > 0 ? (DUP_HI - DUP_PH + 1) : 0)

#define LAS __attribute__((address_space(3)))
typedef unsigned short bf16_t;
typedef short bf16x8 __attribute__((ext_vector_type(8)));
typedef float f32x4 __attribute__((ext_vector_type(4)));
typedef float f32x2 __attribute__((ext_vector_type(2)));
typedef unsigned u32x4 __attribute__((ext_vector_type(4)));
typedef unsigned u32x2 __attribute__((ext_vector_type(2)));

constexpr int BATCH = 2, SEQ = 8192, D = 1024, M = BATCH * SEQ, FF = 2752, FFP = 2816, NW1 = 2 * FFP;
constexpr int MODN = 9216;
constexpr float EPS = 1e-6f;
constexpr int NWAVES = 8;
constexpr int NPHASES = 17;

constexpr size_t MiB = 1u << 20;
constexpr size_t WS_CTL = 0, CTL_ZERO_BYTES = 65536;
constexpr int CW_BAR = 4096;
constexpr size_t WS_MOD = 1 * MiB;
constexpr size_t WS_CONST = 1 * MiB + 512 * 1024;
constexpr size_t WS_SW = 1 * MiB + 640 * 1024;
constexpr size_t WS_A16 = 2 * MiB;
constexpr size_t WS_WPOOL = 3 * MiB;
constexpr size_t WS_SS = 3 * MiB + 512 * 1024;
constexpr size_t WS_WGLU = 4 * MiB;
constexpr size_t WS_EBT = 8 * MiB;
constexpr size_t WS_TFBT = 16 * MiB;
constexpr size_t WS_WIN = 32 * MiB;
constexpr size_t WS_WOUT = 76 * MiB;
constexpr size_t WS_XN = 98 * MiB;
constexpr size_t WS_ACT = 130 * MiB;
constexpr size_t WS_S = 218 * MiB;
constexpr size_t WS_END = 282 * MiB;
constexpr size_t WIN_ELEMS = (size_t)NW1 * D, WOUT_ELEMS = (size_t)D * FFP;

namespace pg8 {
constexpr int BM = 256, BK = 64, HALF = 128, HTB = HALF * BK * 2, STAGE_BYTES = 8 * HTB, NXCD = 8, WGM = 8;
__host__ __device__ __forceinline__ int lds_byte(int r, int c) { const int st = (r >> 4) * 2 + (c >> 5), rr = r & 15, cc = c & 31, ob = rr * 64 + cc * 2; return st * 1024 + (ob ^ (((ob >> 9) & 1) << 5)); }
__host__ __device__ __forceinline__ void stage_rc(int b, int& R, int& C) { const int st = b / 1024, sb = b % 1024, swz = sb ^ (((sb >> 9) & 1) << 5); R = (st >> 1) * 16 + swz / 64; C = (st & 1) * 32 + (swz % 64) / 2; }
__host__ __device__ __forceinline__ int perm32(int rho) { const int n = rho >> 4, i = rho & 15; return 8 * (i >> 2) + 4 * n + (i & 3); }

struct Unit { int pm, pn, z; };
struct Gemm { const bf16_t* A; const bf16_t* Bt; int lda, ldb, K, koffA; size_t zsA, zsB; };

struct StaticOrder {
    int nM, nN, nwg, G, c;
    __device__ __forceinline__ void init(int M_, int N_, int G_, int c_) { nM = M_ / BM; nN = N_ / BM; nwg = nM * nN; G = G_; c = c_; }
    __device__ __forceinline__ bool next(int i, Unit& u) const {
        const long L = (long)i * G + c; if (L >= nwg) return false;
        int wgid = (int)L; { const int q = nwg / NXCD, r = nwg % NXCD, xcd = wgid % NXCD, off = wgid / NXCD; wgid = (xcd < r ? xcd * (q + 1) : r * (q + 1) + (xcd - r) * q) + off; }
        const int nig = WGM * nN, gid = wgid / nig, fm = gid * WGM, gsz = (nM - fm) < WGM ? (nM - fm) : WGM;
        u.pm = fm + ((wgid % nig) % gsz); u.pn = (wgid % nig) / gsz; u.z = 0; return true;
    }
};
struct GroupOrder {
    int n, G, c;
    __device__ __forceinline__ bool next(int i, Unit& u) const { const int L = i * G + c; if (L >= n) return false;
        const int xcd = L & 7, idx = L >> 3, combo = (idx >> 2) * 8 + xcd; u.z = (combo >> 2) * 4 + (idx & 3); u.pm = combo & 3; u.pn = 0; return true; }
};

__device__ __forceinline__ unsigned cvt_pk_bf16(float lo, float hi) { unsigned r; asm volatile("v_cvt_pk_bf16_f32 %0, %1, %2" : "=v"(r) : "v"(lo), "v"(hi)); return r; }
__device__ __forceinline__ float sigmoidf_(float x) { return __builtin_amdgcn_rcpf(1.0f + __builtin_amdgcn_exp2f(-1.4426950408889634f * x)); }
__device__ __forceinline__ float siluf_(float x) { return x * sigmoidf_(x); }
__device__ __forceinline__ float gelu_tanh_(float y) { const float z = 0.7978845608028654f * (y + 0.044715f * y * y * y); return y * sigmoidf_(2.0f * z); }

typedef f32x4 Acc[2][2][4][2];

template <int NB>
__device__ __forceinline__ void ss_publish(const float (&q)[NB][2][4], float* SS, int pm, int slot0, int wr, int wc, int fr, int fq, LAS float* P) {
#pragma unroll
    for (int bj = 0; bj < NB; ++bj)
#pragma unroll
        for (int ai = 0; ai < 2; ++ai)
#pragma unroll
            for (int m = 0; m < 4; ++m) { float v = q[bj][ai][m]; v += __shfl_xor(v, 16); v += __shfl_xor(v, 32);
                if (fq == 0) P[(bj * 256 + ai * HALF + wr * 64 + m * 16 + fr) * 4 + wc] = v; }
    asm volatile("s_waitcnt lgkmcnt(0)" ::: "memory"); __builtin_amdgcn_s_barrier(); asm volatile("" ::: "memory");
    const int tid = (wr * 4 + wc) * 64 + fq * 16 + fr;
    if (tid < NB * 256) { const f32x4 v = *(const LAS f32x4*)(P + tid * 4); SS[(size_t)(pm * BM + (tid & 255)) * 8 + slot0 + (tid >> 8)] = (v.x + v.y) + (v.z + v.w); }
}
__device__ __forceinline__ float rstd_from_ss(const float* SS, int row) {
    const f32x4 a = *(const f32x4*)(SS + (size_t)row * 8), b = *(const f32x4*)(SS + (size_t)row * 8 + 4);
    return 1.0f / sqrtf(((a.x + a.y) + (a.z + a.w) + (b.x + b.y) + (b.z + b.w)) * (1.0f / D) + EPS);
}

struct EpiSwiGLU {
    static constexpr bool PERM = true; static constexpr bool LDS_TAIL = false;
    bf16_t* O; int ldc; const float* SS; const float* SW;
    __device__ __forceinline__ void operator()(const Acc& acc, const Unit& u, int wr, int wc, int fr, int fq) const {
        const int row0 = u.pm * BM + wr * 64 + fr, col0 = u.pn * HALF + wc * 32 + 8 * fq, b = u.pm >> 5;
        const float* swp = SW + (size_t)b * NW1 + u.pn * BM + wc * 32 + 8 * fq;
        const f32x4 sg0 = *(const f32x4*)(swp), sg1 = *(const f32x4*)(swp + 4), su0 = *(const f32x4*)(swp + HALF), su1 = *(const f32x4*)(swp + HALF + 4);
#pragma unroll
        for (int ai = 0; ai < 2; ++ai)
#pragma unroll
            for (int m = 0; m < 4; ++m) {
                const int row = row0 + ai * HALF + m * 16;
                const float rs = rstd_from_ss(SS, row);
                bf16_t* rowp = O + (size_t)row * ldc + col0;
                const f32x4 g0 = acc[ai][0][m][0] * rs + sg0, g1 = acc[ai][0][m][1] * rs + sg1, u0 = acc[ai][1][m][0] * rs + su0, u1 = acc[ai][1][m][1] * rs + su1;
                u32x4 w;
                w.x = cvt_pk_bf16(siluf_(g0[0]) * u0[0], siluf_(g0[1]) * u0[1]); w.y = cvt_pk_bf16(siluf_(g0[2]) * u0[2], siluf_(g0[3]) * u0[3]);
                w.z = cvt_pk_bf16(siluf_(g1[0]) * u1[0], siluf_(g1[1]) * u1[1]); w.w = cvt_pk_bf16(siluf_(g1[2]) * u1[2], siluf_(g1[3]) * u1[3]);
                *(u32x4*)rowp = w;
            }
    }
};
struct EpiResid {
    static constexpr bool PERM = true, LDS_TAIL = true;
    const float* xin; float* xout; const float* gate; const float* bias; const float* scl; const float* gnext; const float* scnext; bf16_t* XP; float* SS; LAS float* P; int emit;
    __device__ __forceinline__ void tail(const Acc& acc, const Unit& u, int wr, int wc, int fr, int fq, LAS unsigned char* lds, int lane) const {
        const int b = u.pm >> 5, col0 = u.pn * BM + wc * 32 + 8 * fq, wid = wr * 4 + wc;
        const size_t off0 = (size_t)(u.pm * BM + wr * 64 + fr) * D + col0;
        f32x4 a1[2][2], a0[2][2], an[2][2];
#pragma unroll
        for (int bj = 0; bj < 2; ++bj)
#pragma unroll
            for (int n = 0; n < 2; ++n) { const int c = col0 + bj * HALF + 4 * n;
                const f32x4 gv = *(const f32x4*)(gate + (size_t)b * MODN + c), bv = *(const f32x4*)(bias + c), sv = *(const f32x4*)(scl + c);
                a1[bj][n] = gv * sv; a0[bj][n] = a1[bj][n] * bv;
                an[bj][n] = *(const f32x4*)(gnext + c) * (*(const f32x4*)(scnext + (size_t)b * MODN + c) + 1.0f); }
        float q[2][2][4];
        const float* xg = xin + (size_t)(u.pm * BM) * D + u.pn * BM + lane * 4;
#pragma unroll
        for (int R = 0; R < 2; ++R) {
#pragma unroll
            for (int i = 0; i < 16; ++i) { const int rr = wid * 16 + i;
                __builtin_amdgcn_global_load_lds((const unsigned*)(xg + (size_t)(128 * R + rr) * D), (LAS unsigned*)(lds + (rr >> 6) * 66560 + (rr & 63) * 1040), 16, 0, 0); }
            asm volatile("s_waitcnt vmcnt(0)" ::: "memory"); __builtin_amdgcn_s_barrier(); asm volatile("" ::: "memory");
#pragma unroll
            for (int m = 0; m < 4; ++m) {
                const LAS unsigned char* rp = lds + wr * 66560 + (16 * m + fr) * 1040 + (wc * 32 + 8 * fq) * 4;
#pragma unroll
                for (int bj = 0; bj < 2; ++bj) {
                    const f32x4 x0 = *(const LAS f32x4*)(rp + bj * 512), x1 = *(const LAS f32x4*)(rp + bj * 512 + 16);
                    const size_t ro = off0 + bj * HALF + (size_t)(R * HALF + m * 16) * D;
                    const f32x4 o0 = x0 + acc[R][bj][m][0] * a1[bj][0] + a0[bj][0], o1 = x1 + acc[R][bj][m][1] * a1[bj][1] + a0[bj][1];
                    __builtin_nontemporal_store(o0, (f32x4*)(xout + ro)); __builtin_nontemporal_store(o1, (f32x4*)(xout + ro + 4));
                    q[bj][R][m] = ((o0.x * o0.x + o0.y * o0.y) + (o0.z * o0.z + o0.w * o0.w)) + ((o1.x * o1.x + o1.y * o1.y) + (o1.z * o1.z + o1.w * o1.w));
                    if (emit) { const f32x4 h0 = o0 * an[bj][0], h1 = o1 * an[bj][1]; u32x4 w; w.x = cvt_pk_bf16(h0.x, h0.y); w.y = cvt_pk_bf16(h0.z, h0.w); w.z = cvt_pk_bf16(h1.x, h1.y); w.w = cvt_pk_bf16(h1.z, h1.w);
                        *(u32x4*)(XP + ro) = w; }
                }
            }
            asm volatile("s_waitcnt lgkmcnt(0)" ::: "memory"); __builtin_amdgcn_s_barrier(); asm volatile("" ::: "memory");
        }
        ss_publish<2>(q, SS, u.pm, 2 * u.pn, wr, wc, fr, fq, P);
    }
};
struct EpiGLU {
    static constexpr bool PERM = true; static constexpr bool LDS_TAIL = false;
    const float* xin; float* xout; const float* gate; const float* gb; const float* gnext; const float* scnext; bf16_t* XP; float* SS; LAS float* P;
    __device__ __forceinline__ void operator()(const Acc& acc, const Unit& u, int wr, int wc, int fr, int fq) const {
        const int b = u.pm >> 5, f0 = u.pn * HALF + wc * 32 + 8 * fq;
        const size_t off0 = (size_t)(u.pm * BM + wr * 64 + fr) * D + f0;
        f32x4 gv[2], b1[2], b2[2], an[2];
#pragma unroll
        for (int n = 0; n < 2; ++n) { const int c = f0 + 4 * n; gv[n] = *(const f32x4*)(gate + (size_t)b * MODN + c); b1[n] = *(const f32x4*)(gb + c); b2[n] = *(const f32x4*)(gb + D + c);
            an[n] = *(const f32x4*)(gnext + c) * (*(const f32x4*)(scnext + (size_t)b * MODN + c) + 1.0f); }
        float q[1][2][4];
#pragma unroll
        for (int ai = 0; ai < 2; ++ai) {
#pragma unroll
            for (int m = 0; m < 4; ++m) {
                const size_t ro = off0 + (size_t)(ai * HALF + m * 16) * D;
                f32x4 o[2];
#pragma unroll
                for (int n = 0; n < 2; ++n) {
                    const f32x4 xi = *(const f32x4*)(xin + ro + 4 * n);
                    const f32x4 z1 = acc[ai][0][m][n] + b1[n], z2 = acc[ai][1][m][n] + b2[n];
#pragma unroll
                    for (int e = 0; e < 4; ++e) o[n][e] = xi[e] + gv[n][e] * z1[e] * sigmoidf_(z2[e]);
                    *(f32x4*)(xout + ro + 4 * n) = o[n];
                }
                q[0][ai][m] = ((o[0].x * o[0].x + o[0].y * o[0].y) + (o[0].z * o[0].z + o[0].w * o[0].w)) + ((o[1].x * o[1].x + o[1].y * o[1].y) + (o[1].z * o[1].z + o[1].w * o[1].w));
                const f32x4 h0 = o[0] * an[0], h1 = o[1] * an[1]; u32x4 w; w.x = cvt_pk_bf16(h0.x, h0.y); w.y = cvt_pk_bf16(h0.z, h0.w); w.z = cvt_pk_bf16(h1.x, h1.y); w.w = cvt_pk_bf16(h1.z, h1.w);
                *(u32x4*)(XP + ro) = w;
            }
            asm volatile("" ::: "memory");
        }
        ss_publish<1>(q, SS, u.pm, u.pn, wr, wc, fr, fq, P);
    }
};
struct EpiS16 {
    static constexpr bool PERM = false; static constexpr bool LDS_TAIL = false;
    bf16_t* O;
    __device__ __forceinline__ void operator()(const Acc& acc, const Unit& u, int wr, int wc, int fr, int fq) const {
        bf16_t* base = O + (size_t)u.z * 1024 * 256 + (size_t)(u.pm * BM + wr * 64 + fr) * 256 + wc * 32 + 4 * fq;
#pragma unroll
        for (int ai = 0; ai < 2; ++ai)
#pragma unroll
            for (int m = 0; m < 4; ++m) {
                bf16_t* rowp = base + (size_t)(ai * HALF + m * 16) * 256;
                asm volatile("" : "+v"(rowp));
#pragma unroll
                for (int bj = 0; bj < 2; ++bj)
#pragma unroll
                    for (int n = 0; n < 2; ++n) { const f32x4 v = acc[ai][bj][m][n]; u32x2 w; w.x = cvt_pk_bf16(v[0], v[1]); w.y = cvt_pk_bf16(v[2], v[3]); *(u32x2*)(rowp + bj * HALF + n * 16) = w; }
            }
    }
};
struct EpiS5Y {
    static constexpr bool PERM = false; static constexpr bool LDS_TAIL = false;
    bf16_t* Y;
    __device__ __forceinline__ void operator()(const Acc& acc, const Unit& u, int wr, int wc, int fr, int fq) const {
#pragma unroll
        for (int ai = 0; ai < 2; ++ai)
#pragma unroll
            for (int m = 0; m < 4; ++m) {
                const int r = u.pm * BM + ai * HALF + wr * 64 + m * 16 + fr;
#pragma unroll
                for (int bj = 0; bj < 2; ++bj)
#pragma unroll
                    for (int n = 0; n < 2; ++n) {
                        const int i = 8 * bj + 2 * wc + n;
                        const f32x4 v = acc[ai][bj][m][n];
                        u32x2 w; w.x = cvt_pk_bf16(gelu_tanh_(v[0]), gelu_tanh_(v[1])); w.y = cvt_pk_bf16(gelu_tanh_(v[2]), gelu_tanh_(v[3]));
                        *(u32x2*)(Y + (size_t)(r * 16 + i) * D + u.z * 16 + 4 * fq) = w;
                    }
            }
    }
};

template <class Epi, class Sched>
__device__ __forceinline__ void gemm_phase(LAS unsigned char* lds, const Gemm g, const Sched& S, const Epi& E, const int tid_in) {
    int tid = tid_in; asm volatile("" : "+v"(tid));
    const int wid = __builtin_amdgcn_readfirstlane(tid >> 6), lane = tid & 63, wr = wid >> 2, wc = wid & 3, fr = lane & 15, fq = lane >> 4;
    const int K = g.K, nt = K / BK;
    unsigned voffA[2], voffB[2];
#pragma unroll
    for (int i = 0; i < 2; ++i) { int R, C; stage_rc(tid * 16 + i * 8192, R, C); const int Rb = Epi::PERM ? ((R & ~31) + perm32(R & 31)) : R;
        voffA[i] = (unsigned)(R * g.lda + C) * 2u; voffB[i] = (unsigned)(Rb * g.ldb + C) * 2u; }
    const size_t kstep = (size_t)(BK * 2);
    const size_t hstepA = (size_t)HALF * g.lda * 2, hstepB = (size_t)HALF * g.ldb * 2;
    const unsigned ldsw = (unsigned)wid * 1024u;
    const int aoff = lds_byte(wr * 64 + fr, fq * 8), boff = lds_byte(wc * 32 + fr, fq * 8);
#define PG8_UA(u) ((const char*)g.A + ((size_t)(u).z * g.zsA + (size_t)(u).pm * BM * g.lda + (size_t)(u).pn * g.koffA) * 2)
#define PG8_UB(u) ((const char*)g.Bt + ((size_t)(u).z * g.zsB + (size_t)(u).pn * BM * g.ldb) * 2)
#define PG8_SA(b, h) (((b) * 2 + (h)) * HTB)
#define PG8_SB(b, h) ((4 + (b) * 2 + (h)) * HTB)
#define PG8_STAGE(bufoff, gbase, voff) do { _Pragma("unroll") for (int _i = 0; _i < 2; ++_i) \
        __builtin_amdgcn_global_load_lds((const unsigned*)((const char*)(gbase) + (voff)[_i]), (LAS unsigned*)(lds + (bufoff) + ldsw + _i * 8192), 16, 0, 0); } while (0)
#define PG8_LDA(dst, b, h) do { _Pragma("unroll") for (int m = 0; m < 4; ++m) _Pragma("unroll") for (int k = 0; k < 2; ++k) dst[m][k] = *(const LAS bf16x8*)(lds + PG8_SA(b, h) + aoff + m * 2048 + k * 1024); } while (0)
#define PG8_LDB(dst, b, h) do { _Pragma("unroll") for (int n = 0; n < 2; ++n) _Pragma("unroll") for (int k = 0; k < 2; ++k) dst[n][k] = *(const LAS bf16x8*)(lds + PG8_SB(b, h) + boff + n * 2048 + k * 1024); } while (0)
#define PG8_MMA(ai, bj, At, Bt) do { __builtin_amdgcn_s_setprio(1); _Pragma("unroll") for (int m = 0; m < 4; ++m) _Pragma("unroll") for (int n = 0; n < 2; ++n) _Pragma("unroll") for (int k = 0; k < 2; ++k) \
        acc[ai][bj][m][n] = __builtin_amdgcn_mfma_f32_16x16x32_bf16(Bt[n][k], At[m][k], acc[ai][bj][m][n], 0, 0, 0); __builtin_amdgcn_s_setprio(0); } while (0)
#define PG8_WAIT_V(n) asm volatile("s_waitcnt vmcnt(" #n ")" ::: "memory")
#define PG8_WAIT_L(n) asm volatile("s_waitcnt lgkmcnt(" #n ")" ::: "memory")
#define PG8_BAR __builtin_amdgcn_s_barrier()
#define PG8_SCHED __builtin_amdgcn_sched_barrier(0)
    Unit cur, nxt; int ui = 0;
  for (int u0 = 0;; ++u0) {
    if (!S.next(u0, cur)) break;
    ui = u0;
    Acc acc;
    float zero_ = 0.f; asm volatile("" : "+v"(zero_));
#pragma unroll
    for (int a = 0; a < 2; ++a)
#pragma unroll
        for (int b = 0; b < 2; ++b)
#pragma unroll
            for (int m = 0; m < 4; ++m)
#pragma unroll
                for (int n = 0; n < 2; ++n) acc[a][b][m][n] = (f32x4){zero_, zero_, zero_, zero_};
    bf16x8 At[4][2], B0[2][2], B1[2][2];
    const char* cA = PG8_UA(cur); const char* cB = PG8_UB(cur);
    PG8_STAGE(PG8_SB(0, 0), cB, voffB); PG8_STAGE(PG8_SB(0, 1), cB + hstepB, voffB); PG8_STAGE(PG8_SA(0, 0), cA, voffA); PG8_STAGE(PG8_SA(0, 1), cA + hstepA, voffA);
    if (wr == 1) PG8_BAR;
    PG8_WAIT_V(2); PG8_BAR;
    PG8_STAGE(PG8_SB(1, 0), cB + kstep, voffB); PG8_STAGE(PG8_SA(1, 0), cA + kstep, voffA); PG8_STAGE(PG8_SB(1, 1), cB + hstepB + kstep, voffB);
    PG8_WAIT_V(6); PG8_BAR;
    for (;;) {
        const bool has_next = Epi::LDS_TAIL ? false : S.next(ui + 1, nxt);
        const char* nA = has_next ? PG8_UA(nxt) : cA; const char* nB = has_next ? PG8_UB(nxt) : cB;
#pragma nounroll
        for (int t = 0; t < nt; t += 2) {
            const bool last = (t == nt - 2);
            const char* a1 = cA + (size_t)(t + 1) * kstep;
            const char* a2 = last ? nA : cA + (size_t)(t + 2) * kstep; const char* b2 = last ? nB : cB + (size_t)(t + 2) * kstep;
            const char* a3 = a2 + kstep; const char* b3 = b2 + kstep;
            PG8_LDB(B0, 0, 0); PG8_LDB(B1, 0, 1); PG8_SCHED; PG8_LDA(At, 0, 0); PG8_STAGE(PG8_SA(1, 1), a1 + hstepA, voffA);
            PG8_WAIT_V(8); PG8_WAIT_L(0); PG8_BAR; PG8_MMA(0, 0, At, B0); PG8_MMA(0, 1, At, B1); PG8_BAR; PG8_SCHED;
            PG8_LDA(At, 0, 1); PG8_STAGE(PG8_SB(0, 0), b2, voffB); PG8_STAGE(PG8_SB(0, 1), b2 + hstepB, voffB); PG8_STAGE(PG8_SA(0, 0), a2, voffA);
            PG8_WAIT_V(8); PG8_WAIT_L(0); PG8_BAR; PG8_MMA(1, 0, At, B0); PG8_MMA(1, 1, At, B1); PG8_BAR; PG8_SCHED;
            PG8_LDB(B0, 1, 0); PG8_LDB(B1, 1, 1); PG8_SCHED; PG8_LDA(At, 1, 0); PG8_STAGE(PG8_SA(0, 1), a2 + hstepA, voffA);
            PG8_WAIT_V(8); PG8_WAIT_L(0); PG8_BAR; PG8_MMA(0, 0, At, B0); PG8_MMA(0, 1, At, B1); PG8_BAR; PG8_SCHED;
            PG8_LDA(At, 1, 1); PG8_STAGE(PG8_SB(1, 0), b3, voffB); PG8_STAGE(PG8_SB(1, 1), b3 + hstepB, voffB); PG8_STAGE(PG8_SA(1, 0), a3, voffA);
            PG8_WAIT_V(8); PG8_WAIT_L(0); PG8_BAR; PG8_MMA(1, 0, At, B0); PG8_MMA(1, 1, At, B1); PG8_BAR; PG8_SCHED;
        }
        if (wr == 0) PG8_BAR;
        { int fr2 = fr, fq2 = fq; asm volatile("" : "+v"(fr2), "+v"(fq2));
          if constexpr (Epi::LDS_TAIL) { PG8_WAIT_V(0); PG8_BAR; E.tail(acc, cur, wr, wc, fr2, fq2, lds, lane); }
          else E(acc, cur, wr, wc, fr2, fq2); }
        if (!has_next) break;
#pragma unroll
        for (int a = 0; a < 2; ++a)
#pragma unroll
            for (int b = 0; b < 2; ++b)
#pragma unroll
                for (int m = 0; m < 4; ++m)
#pragma unroll
                    for (int n = 0; n < 2; ++n) acc[a][b][m][n] = (f32x4){zero_, zero_, zero_, zero_};
        cur = nxt; cA = nA; cB = nB; ++ui;
        if (wr == 1) PG8_BAR;
    }
    PG8_WAIT_V(0);
    PG8_BAR;
    if constexpr (!Epi::LDS_TAIL) break;
  }
#undef PG8_UA
#undef PG8_UB
#undef PG8_SA
#undef PG8_SB
#undef PG8_STAGE
#undef PG8_LDA
#undef PG8_LDB
#undef PG8_MMA
#undef PG8_WAIT_V
#undef PG8_WAIT_L
#undef PG8_BAR
#undef PG8_SCHED
}
}

#define LDS_WAIT() asm volatile("s_waitcnt lgkmcnt(0)" ::: "memory")
__device__ __forceinline__ unsigned f2bf(float f) { unsigned u = __builtin_bit_cast(unsigned, f); return (u + 0x7fffu + ((u >> 16) & 1u)) >> 16; }
__device__ __forceinline__ unsigned pk2(float lo, float hi) { return f2bf(lo) | (f2bf(hi) << 16); }
__device__ __forceinline__ float bf_lo(unsigned w) { return __builtin_bit_cast(float, w << 16); }
__device__ __forceinline__ float bf_hi(unsigned w) { return __builtin_bit_cast(float, w & 0xffff0000u); }
__device__ __forceinline__ float wave_sum(float v) {
#define WS_STEP(k) v += __builtin_bit_cast(float, __builtin_amdgcn_ds_swizzle(__builtin_bit_cast(int, v), 0x1f | ((k) << 10)))
    WS_STEP(1); WS_STEP(2); WS_STEP(4); WS_STEP(8); WS_STEP(16);
#undef WS_STEP
    const int iv = __builtin_bit_cast(int, v);
    return __builtin_bit_cast(float, __builtin_amdgcn_readlane(iv, 0)) + __builtin_bit_cast(float, __builtin_amdgcn_readlane(iv, 32));
}

typedef __attribute__((address_space(1))) unsigned gu32;
#define XB_TMO      128
#define XB_XCNT(j)  (256  + 64 * (j))
#define XB_XSUB(j)  (1280 + 64 * (j))
#define XB_XGEN(j)  (2304 + 64 * (j))
#define XB_TOP      3328
#define XB_TOPGEN   3392
#define XCD_BAR_WORDS 3456
#define XB_SPIN_CAP (1u << 18)

__device__ __forceinline__ unsigned xb_ld(unsigned* p)              { return __hip_atomic_load(p, __ATOMIC_RELAXED, __HIP_MEMORY_SCOPE_AGENT); }
__device__ __forceinline__ unsigned xb_add(unsigned* p, unsigned v) { return __hip_atomic_fetch_add(p, v, __ATOMIC_RELAXED, __HIP_MEMORY_SCOPE_AGENT); }
__device__ __forceinline__ unsigned xb_xcc_id() { return (unsigned)__builtin_amdgcn_s_getreg((3 << 11) | 20) & 0xFu; }
#define XB_SPIN(cond, bar) do { unsigned _sp = 0; while (cond) { __builtin_amdgcn_s_sleep(1); \
    if ((++_sp & 255u) == 0u) { if (xb_ld(&(bar)[XB_TMO])) break; if (_sp > XB_SPIN_CAP) { atomicAdd(&(bar)[XB_TMO], 1u); break; } } } } while (0)

struct XcdBarrier {
    unsigned* bar; unsigned x;
    volatile LAS unsigned* st;
};

__device__ __forceinline__ XcdBarrier xcd_barrier_post(unsigned* bar, volatile LAS unsigned* st) {
    XcdBarrier b; b.bar = bar; b.x = xb_xcc_id(); b.st = st;
    if (threadIdx.x == 0) (void)xb_add(&bar[XB_XCNT(b.x)], 1u);
    return b;
}
__device__ __forceinline__ void xcd_barrier_complete(unsigned* bar, unsigned x, unsigned& nloc, unsigned& nx) {
    const unsigned G = gridDim.x * gridDim.y * gridDim.z;
    unsigned sum, cnt, mine, sp = 0u;
    for (;;) {
        sum = 0u; cnt = 0u; mine = 0u;
#pragma unroll
        for (unsigned j = 0; j < 16; ++j) { const unsigned c = xb_ld(&bar[XB_XCNT(j)]); sum += c; cnt += (c > 0u) ? 1u : 0u; mine = (j == x) ? c : mine; }
        if (sum == G) break;
        __builtin_amdgcn_s_sleep(1);
        if ((++sp & 255u) == 0u) { if (xb_ld(&bar[XB_TMO])) break; if (sp > XB_SPIN_CAP) { atomicAdd(&bar[XB_TMO], 1u); break; } }
    }
    nloc = mine > 0u ? mine : 1u; nx = cnt > 0u ? cnt : 1u;
}

__device__ __forceinline__ void xcd_barrier(const XcdBarrier& b) {
    asm volatile("s_waitcnt vmcnt(0)" ::: "memory");
    __syncthreads();
    if (threadIdx.x == 0) {
        unsigned* bar = b.bar;
        __builtin_amdgcn_s_waitcnt(0);
        unsigned nloc = b.st[0], nx = b.st[1];
        if (nloc == 0u) { xcd_barrier_complete(bar, b.x, nloc, nx); b.st[0] = nloc; b.st[1] = nx; }
        const unsigned old = xb_add(&bar[XB_XSUB(b.x)], 1u);
        const unsigned gen = old / nloc;
        if (old + 1u == (gen + 1u) * nloc) {
            __builtin_amdgcn_fence(__ATOMIC_RELEASE, "agent");
            asm volatile("s_waitcnt vmcnt(0)" ::: "memory");
            const unsigned og = xb_add(&bar[XB_TOP], 1u);
            const unsigned tg = og / nx;
            if (og + 1u == (tg + 1u) * nx) xb_add(&bar[XB_TOPGEN], 1u);
            else XB_SPIN(xb_ld(&bar[XB_TOPGEN]) == tg, bar);
            __builtin_amdgcn_fence(__ATOMIC_ACQUIRE, "agent");
            xb_add(&bar[XB_XGEN(b.x)], 1u);
            asm volatile("s_waitcnt vmcnt(0)" ::: "memory");
        } else {
            XB_SPIN(xb_ld(&bar[XB_XGEN(b.x)]) == gen, bar);
            __builtin_amdgcn_fence(__ATOMIC_ACQUIRE, "agent");
            asm volatile("s_waitcnt vmcnt(0)" ::: "memory");
        }
    }
    __syncthreads();
}


struct Args {
    const float* in[21]; float* out; unsigned char* ws; int ph_lo, ph_hi, sync, pad;
};

__device__ __forceinline__ void p0_transpose_item(const float* W, int ldw, bf16_t* WT, int ldt, int dest_row0, int k0, int n0, LAS float* scr, int lane) {
#pragma unroll 16
    for (int i = 0; i < 32; ++i) { const int kk = 2 * i + (lane >> 5); scr[kk * 33 + (lane & 31)] = W[(size_t)(k0 + kk) * ldw + n0 + (lane & 31)]; }
    LDS_WAIT(); asm volatile("" ::: "memory");
    const int c = lane & 7;
#pragma unroll
    for (int j = 0; j < 4; ++j) { const int n = (lane >> 3) + 8 * j; const LAS float* s = scr + (8 * c) * 33 + n;
        u32x4 o; o.x = pk2(s[0 * 33], s[1 * 33]); o.y = pk2(s[2 * 33], s[3 * 33]); o.z = pk2(s[4 * 33], s[5 * 33]); o.w = pk2(s[6 * 33], s[7 * 33]);
        *(u32x4*)(WT + (size_t)(dest_row0 + n) * ldt + k0 + 8 * c) = o; }
    LDS_WAIT(); asm volatile("" ::: "memory");
}

__device__ __forceinline__ int il128(int f) { return ((f >> 7) << 8) + (f & 127); }

#define CAS __attribute__((address_space(4)))
__device__ __forceinline__ void p0_prologue(const CAS Args* ap, LAS unsigned char* lds, int vcu, int G, int tid) {
    const CAS Args& a = *ap;
    const int lane = tid & 63, wave = __builtin_amdgcn_readfirstlane(tid >> 6);
    unsigned char* ws = a.ws;
    {
        LAS float* cnd = (LAS float*)lds;
        LAS float* red = (LAS float*)(lds + 8192);
        if (vcu < 144) {
            const float* c = a.in[1];
            for (int i = tid; i < 2 * D; i += 512) { const float v = c[i]; cnd[i] = v / (1.0f + __expf(-v)); }
        }
        __syncthreads();
        for (int it = vcu; it < 144; it += G) {
            const int l = it / 72, ch = it % 72;
            const float* w = a.in[2] + (size_t)l * D * MODN + (size_t)(wave * 128) * MODN + ch * 128 + 2 * lane;
            f32x2 a0 = {0.f, 0.f}, a1 = {0.f, 0.f};
#pragma unroll 16
            for (int k = 0; k < 128; ++k) { const f32x2 wv = *(const f32x2*)(w + (size_t)k * MODN); const float c0 = cnd[wave * 128 + k], c1 = cnd[D + wave * 128 + k]; a0 += wv * c0; a1 += wv * c1; }
            red[(wave * 2 + 0) * 128 + 2 * lane] = a0.x; red[(wave * 2 + 0) * 128 + 2 * lane + 1] = a0.y;
            red[(wave * 2 + 1) * 128 + 2 * lane] = a1.x; red[(wave * 2 + 1) * 128 + 2 * lane + 1] = a1.y;
            __syncthreads();
            if (tid < 256) { const int b = tid >> 7, col = tid & 127; float s = a.in[3][l * MODN + ch * 128 + col];
#pragma unroll
                for (int w8 = 0; w8 < 8; ++w8) s += red[(w8 * 2 + b) * 128 + col];
                ((float*)(ws + WS_MOD))[(l * 2 + b) * MODN + ch * 128 + col] = s; }
            __syncthreads();
        }
    }
    if (vcu == 0) { float* cz = (float*)(ws + WS_CONST); for (int i = tid; i < 2 * D; i += 512) cz[i] = i < D ? 0.0f : 0.5f; }
    {
        LAS float* Wre = (LAS float*)lds;
        LAS float* Wim = Wre + 2048;
        LAS float* Cre = Wim + 2048;
        LAS float* Cim = Cre + 2080;
        LAS float* Kl = Cim + 2080;
        bf16_t* EBT = (bf16_t*)(ws + WS_EBT); bf16_t* TF = (bf16_t*)(ws + WS_TFBT); float* A16 = (float*)(ws + WS_A16);
        for (int it = vcu; it < 1024; it += G) {
            const int g = it >> 4, tau = it & 15;
            {
                const int dir = tid >> 8, hq = (tid >> 6) & 3, p = tid & 63, dg = dir * 64 + g;
                const float dt = expf(a.in[12][dg]);
                const float lr = a.in[10][dg * 64 + p], li = a.in[11][dg * 64 + p];
                const float xr = lr * dt, yi = li * dt;
                float sy, cy; sincosf(yi, &sy, &cy);
                const float mag = expf(xr), ar = mag * cy, ai = mag * sy;
                const float sh = sinf(0.5f * yi);
                const float arm1 = expm1f(xr) * cy - 2.0f * sh * sh;
                const float den = lr * lr + li * li;
                const float fr_ = (arm1 * lr + ai * li) / den, fi_ = (ai * lr - arm1 * li) / den;
                float st, ct; sincosf((float)tau * yi, &st, &ct);
                const float magt = expf((float)tau * xr), atr = magt * ct, ati = magt * st;
                const float a1r = atr * ar - ati * ai, a1i = atr * ai + ati * ar;
                const f32x4 br = *(const f32x4*)(a.in[13] + ((size_t)dg * 64 + p) * 16 + 4 * hq), bi = *(const f32x4*)(a.in[14] + ((size_t)dg * 64 + p) * 16 + 4 * hq);
                float wr4[4], wi4[4];
#pragma unroll
                for (int e = 0; e < 4; ++e) { const float bbr = fr_ * br[e] - fi_ * bi[e], bbi = fr_ * bi[e] + fi_ * br[e];
                    wr4[e] = atr * bbr - ati * bbi; wi4[e] = atr * bbi + ati * bbr;
                    Wre[(dir * 64 + p) * 16 + 4 * hq + e] = wr4[e]; Wim[(dir * 64 + p) * 16 + 4 * hq + e] = wi4[e]; }
                const int j = dir == 0 ? 15 - tau : tau;
                u32x2 er, ei; er.x = pk2(wr4[0], wr4[1]); er.y = pk2(wr4[2], wr4[3]); ei.x = pk2(wi4[0], wi4[1]); ei.y = pk2(wi4[2], wi4[3]);
                *(u32x2*)(EBT + ((size_t)g * 256 + dir * 128 + 2 * p) * 256 + j * 16 + 4 * hq) = er;
                *(u32x2*)(EBT + ((size_t)g * 256 + dir * 128 + 2 * p + 1) * 256 + j * 16 + 4 * hq) = ei;
                const int irow = dir == 0 ? tau : 15 - tau;
#pragma unroll
                for (int e = 0; e < 4; ++e) { const int hp = 4 * hq + e;
                    const float cr = a.in[15][((size_t)dg * 16 + hp) * 64 + p], ci = a.in[16][((size_t)dg * 16 + hp) * 64 + p];
                    Cre[(dir * 16 + hp) * 65 + p] = cr; Cim[(dir * 16 + hp) * 65 + p] = ci;
                    const float car = cr * a1r - ci * a1i, cai = cr * a1i + ci * a1r;
                    bf16_t* dst = TF + ((size_t)g * 256 + irow * 16 + hp) * 512 + 256 + dir * 128 + p;
                    dst[0] = (bf16_t)f2bf(car); dst[64] = (bf16_t)f2bf(-cai); }
                if (tau == 15 && hq == 0) { A16[((size_t)dg * 64 + p) * 2] = a1r; A16[((size_t)dg * 64 + p) * 2 + 1] = a1i; }
            }
            __syncthreads();
            {
                const int dir = tid >> 8, hp = (tid >> 4) & 15, h = tid & 15;
                float k = 0.f;
#pragma unroll 8
                for (int p = 0; p < 64; ++p) k += Cre[(dir * 16 + hp) * 65 + p] * Wre[(dir * 64 + p) * 16 + h] - Cim[(dir * 16 + hp) * 65 + p] * Wim[(dir * 64 + p) * 16 + h];
                if (tau > 0) {
                    for (int i = 0; i < 16 - tau; ++i) { const int ii = dir == 0 ? i + tau : i, jj = dir == 0 ? i : i + tau;
                        TF[((size_t)g * 256 + ii * 16 + hp) * 512 + jj * 16 + h] = (bf16_t)f2bf(k); }
                } else {
                    Kl[dir * 256 + hp * 16 + h] = k;
                    __syncthreads();
                    if (dir == 0) { const float v = Kl[hp * 16 + h] + Kl[256 + hp * 16 + h] + (h == hp ? a.in[17][g * 16 + h] : 0.f);
                        for (int i = 0; i < 16; ++i) TF[((size_t)g * 256 + i * 16 + hp) * 512 + i * 16 + h] = (bf16_t)f2bf(v); }
                }
            }
            __syncthreads();
        }
    }
    {
        LAS float* scr = (LAS float*)(lds + wave * 16384);
        const int gw = vcu * NWAVES + wave, NGW = G * NWAVES;
        constexpr int I_IN = 16 * 172, I_OUT = 43 * 32, I_POOL = 4 * 8, I_GLU = 16 * 64, I_Z1 = 128, I_Z2 = 128;
        constexpr int NITEMS = 4 * I_IN + 4 * I_OUT + 4 * I_POOL + I_GLU + 4 * I_Z1 + 4 * I_Z2;
        bf16_t* WIN = (bf16_t*)(ws + WS_WIN); bf16_t* WOUT = (bf16_t*)(ws + WS_WOUT); bf16_t* WPOOL = (bf16_t*)(ws + WS_WPOOL); bf16_t* WGLU = (bf16_t*)(ws + WS_WGLU);
        for (int it = gw; it < NITEMS; it += NGW) {
            int r = it;
            if (r < 4 * I_IN) { const int lf = r / I_IN, rr = r % I_IN, kb = rr / 172, nb = rr % 172, n0 = 32 * nb;
                const int dest = n0 < FF ? il128(n0) : il128(n0 - FF) + 128;
                p0_transpose_item(a.in[5] + (size_t)lf * D * 2 * FF, 2 * FF, WIN + (size_t)lf * WIN_ELEMS, D, dest, 64 * kb, n0, scr, lane); continue; }
            r -= 4 * I_IN;
            if (r < 4 * I_OUT) { const int lf = r / I_OUT, rr = r % I_OUT, kb = rr / 32, nb = rr % 32;
                p0_transpose_item(a.in[6] + (size_t)lf * FF * D, D, WOUT + (size_t)lf * WOUT_ELEMS, FFP, 32 * nb, 64 * kb, 32 * nb, scr, lane); continue; }
            r -= 4 * I_OUT;
            if (r < 4 * I_POOL) { const int gi = r / I_POOL, rr = r % I_POOL, kb = rr / 8, nb = rr % 8;
                p0_transpose_item(a.in[7] + (size_t)gi * 65536, 256, WPOOL, 256, gi * 256 + 32 * nb, 64 * kb, 32 * nb, scr, lane); continue; }
            r -= 4 * I_POOL;
            if (r < I_GLU) { const int kb = r / 64, nb = r % 64, n0 = 32 * nb;
                const int dest = n0 < D ? il128(n0) : il128(n0 - D) + 128;
                p0_transpose_item(a.in[18], 2 * D, WGLU, D, dest, 64 * kb, n0, scr, lane); continue; }
            r -= I_GLU;
            if (r < 4 * I_Z1) { const int lf = r / I_Z1, rr = r % I_Z1;
                const int row = 21 * 256 + (rr < 64 ? 64 + rr : 192 + (rr - 64));
                u32x4* p = (u32x4*)(WIN + (size_t)lf * WIN_ELEMS + (size_t)row * D);
                p[lane] = (u32x4){0u, 0u, 0u, 0u}; p[64 + lane] = (u32x4){0u, 0u, 0u, 0u}; continue; }
            r -= 4 * I_Z1;
            { const int lf = r / I_Z2, rr = r % I_Z2;
                const int row = rr * 8 + (lane >> 3);
                *(u32x4*)(WOUT + (size_t)lf * WOUT_ELEMS + (size_t)row * FFP + FF + 8 * (lane & 7)) = (u32x4){0u, 0u, 0u, 0u}; }
        }
    }
}

template <int MODE>
__device__ __forceinline__ void norm_phase(const float* xin, const float* gvec, const float* modp  , void* outp, float* SS, int vcu, int G, int tid) {
    const int lane = tid & 63, wave = __builtin_amdgcn_readfirstlane(tid >> 6);
    const int gw = vcu * NWAVES + wave, NGW = G * NWAVES;
    for (int rb = gw; rb < M / 8; rb += NGW) {
        const int b = rb >> 10;
        f32x4 av[4], sv[4];
#pragma unroll
        for (int j = 0; j < 4; ++j) {
            const int col = 256 * j + 4 * lane;
            const f32x4 gg = *(const f32x4*)(gvec + col);
            if (MODE == 2) { av[j] = gg; sv[j] = (f32x4){0.f, 0.f, 0.f, 0.f}; }
            else { const f32x4 sc = *(const f32x4*)(modp + (size_t)b * MODN + D + col); sv[j] = *(const f32x4*)(modp + (size_t)b * MODN + col); av[j] = gg * (sc + 1.0f); }
        }
#pragma unroll 2
        for (int r = 0; r < 8; ++r) {
            const int row = rb * 8 + r;
            const f32x4* xr = (const f32x4*)(xin + (size_t)row * D) + lane;
            f32x4 v[4]; float s = 0.f;
#pragma unroll
            for (int j = 0; j < 4; ++j) { v[j] = xr[64 * j]; s += (v[j].x * v[j].x + v[j].y * v[j].y) + (v[j].z * v[j].z + v[j].w * v[j].w); }
            const float ssum = wave_sum(s);
            const float rstd = 1.0f / sqrtf(ssum * (1.0f / D) + EPS);
            if (MODE == 3) { if (lane < 2) *(f32x4*)(SS + (size_t)row * 8 + 4 * lane) = (f32x4){lane == 0 ? ssum : 0.f, 0.f, 0.f, 0.f}; }
#pragma unroll
            for (int j = 0; j < 4; ++j) {
                if (MODE == 2) { const f32x4 h = v[j] * rstd * av[j]; ((f32x4*)((float*)outp + (size_t)row * D))[64 * j + lane] = h; }
                else if (MODE == 3) { const f32x4 h = v[j] * av[j]; u32x2 w; w.x = pk2(h.x, h.y); w.y = pk2(h.z, h.w); *(u32x2*)((bf16_t*)outp + (size_t)row * D + 256 * j + 4 * lane) = w; }
                else {
                    const f32x4 h = v[j] * rstd * av[j] + sv[j];
                    u32x2 w; w.x = pk2(h.x, h.y); w.y = pk2(h.z, h.w);
                    const int gi = 16 * j + (lane >> 2); *(u32x2*)((bf16_t*)outp + ((size_t)gi * 1024 + (row >> 4)) * 512 + (row & 15) * 16 + 4 * (lane & 3)) = w;
                }
            }
        }
    }
}

__device__ __forceinline__ void sw_phase(const float* MOD, const bf16_t* WIN, float* SW, int vcu, int G, int tid) {
    const int lane = tid & 63, wave = __builtin_amdgcn_readfirstlane(tid >> 6);
    const int gw = vcu * NWAVES + wave, NGW = G * NWAVES;
    for (int it = gw; it < 4 * 512; it += NGW) {
        const int lf = it & 3, s0 = it >> 2, l = lf >> 1, sub = (lf & 1) * 2;
        f32x4 sh[2][4];
#pragma unroll
        for (int b = 0; b < 2; ++b) { const float* sp = MOD + (size_t)(l * 2 + b) * MODN + sub * 3 * D;
            sh[b][0] = *(const f32x4*)(sp + 8 * lane); sh[b][1] = *(const f32x4*)(sp + 8 * lane + 4); sh[b][2] = *(const f32x4*)(sp + 512 + 8 * lane); sh[b][3] = *(const f32x4*)(sp + 512 + 8 * lane + 4); }
        const bf16_t* wbase = WIN + (size_t)lf * WIN_ELEMS + 8 * lane;
        u32x4 w0[11], w1[11];
#pragma unroll
        for (int i = 0; i < 11; ++i) { const bf16_t* wp = wbase + (size_t)(s0 + 512 * i) * D; w0[i] = *(const u32x4*)wp; w1[i] = *(const u32x4*)(wp + 512); }
#pragma unroll
        for (int i = 0; i < 11; ++i) {
            const f32x4 f0 = {bf_lo(w0[i].x), bf_hi(w0[i].x), bf_lo(w0[i].y), bf_hi(w0[i].y)}, f1 = {bf_lo(w0[i].z), bf_hi(w0[i].z), bf_lo(w0[i].w), bf_hi(w0[i].w)};
            const f32x4 f2 = {bf_lo(w1[i].x), bf_hi(w1[i].x), bf_lo(w1[i].y), bf_hi(w1[i].y)}, f3 = {bf_lo(w1[i].z), bf_hi(w1[i].z), bf_lo(w1[i].w), bf_hi(w1[i].w)};
            float s[2];
#pragma unroll
            for (int b = 0; b < 2; ++b) { const f32x4 t = f0 * sh[b][0] + f1 * sh[b][1] + f2 * sh[b][2] + f3 * sh[b][3]; s[b] = wave_sum((t.x + t.y) + (t.z + t.w)); }
            if (lane < 2) SW[(size_t)(lf * 2 + lane) * NW1 + s0 + 512 * i] = lane == 0 ? s[0] : s[1];
        }
    }
}

__device__ __forceinline__ void pool_acc(float (&s)[8], const bf16_t* p, float f) {
    const u32x4 w = *(const u32x4*)p;
    s[0] += f * bf_lo(w.x); s[1] += f * bf_hi(w.x); s[2] += f * bf_lo(w.y); s[3] += f * bf_hi(w.y); s[4] += f * bf_lo(w.z); s[5] += f * bf_hi(w.z); s[6] += f * bf_lo(w.w); s[7] += f * bf_hi(w.w);
}
__device__ __forceinline__ void pool_phase(const bf16_t* XP, const float* SS, bf16_t* PP, int vcu, int G, int tid) {
    const int lane = tid & 63, wave = __builtin_amdgcn_readfirstlane(tid >> 6);
    const int gw = vcu * NWAVES + wave, NGW = G * NWAVES;
    for (int rb = gw; rb < M / 8; rb += NGW) {
        const int base = rb * 8, b = base >> 13, t0 = base & (SEQ - 1);
        float rl = 0.f;
        { const int tq = t0 - 8 + lane; if (lane < 23 && tq >= 0 && tq < SEQ) rl = pg8::rstd_from_ss(SS, b * SEQ + tq); }
        const bf16_t* xb = XP + (size_t)b * SEQ * D;
#pragma unroll
        for (int jj = 0; jj < 2; ++jj) {
            const int col = 512 * jj + 8 * lane, grp = col >> 8, win = 2 << grp, left = win >> 1, right = win - 1 - left;
            float s[8] = {0.f, 0.f, 0.f, 0.f, 0.f, 0.f, 0.f, 0.f};
            const int rli = __builtin_bit_cast(int, rl);
            const int Lmax = jj == 0 ? 2 : 8, Rmax = jj == 0 ? 1 : 7;
            for (int d = -Lmax; d <= Rmax; ++d) { const int q = t0 + d; if (q < 0 || q >= SEQ) continue;
                const float rq = __builtin_bit_cast(float, __builtin_amdgcn_readlane(rli, d + 8));
                pool_acc(s, xb + (size_t)q * D + col, (d >= -left && d <= right) ? rq : 0.f); }
            for (int r = 0; r < 8; ++r) {
                const int t = t0 + r;
                const int lo = max(t - left, 0), hi = min(t + right, SEQ - 1);
                const float inv = 1.0f / (float)(hi - lo + 1);
                const float rt = __builtin_bit_cast(float, __builtin_amdgcn_readlane(rli, r + 8));
                const u32x4 w = *(const u32x4*)(xb + (size_t)t * D + col);
                u32x4 o;
                o.x = pk2(s[0] * inv - rt * bf_lo(w.x), s[1] * inv - rt * bf_hi(w.x)); o.y = pk2(s[2] * inv - rt * bf_lo(w.y), s[3] * inv - rt * bf_hi(w.y));
                o.z = pk2(s[4] * inv - rt * bf_lo(w.z), s[5] * inv - rt * bf_hi(w.z)); o.w = pk2(s[6] * inv - rt * bf_lo(w.w), s[7] * inv - rt * bf_hi(w.w));
                *(u32x4*)(PP + (size_t)(base + r) * D + col) = o;
                const int qa = t + 1 + right, qs = t - left;
                const float fa = __shfl(rl, qa - t0 + 8), fs = __shfl(rl, qs - t0 + 8);
                pool_acc(s, xb + (size_t)min(qa, SEQ - 1) * D + col, qa < SEQ ? fa : 0.f);
                pool_acc(s, xb + (size_t)max(qs, 0) * D + col, qs >= 0 ? -fs : 0.f);
            }
        }
    }
}

template <int SGN>
__device__ __forceinline__ void scan_item(const unsigned* sp  , bf16_t* xp  , float ar, float ai, LAS float* Ese, int wave, int p) {
    float xr = 0.f, xi = 0.f;
#pragma unroll 16
    for (int k = 0; k < 64; ++k) { const unsigned sv = sp[SGN * k * 128]; const float nr = ar * xr - ai * xi + bf_lo(sv), ni = ar * xi + ai * xr + bf_hi(sv); xr = nr; xi = ni; }
    Ese[(wave * 64 + p) * 2] = xr; Ese[(wave * 64 + p) * 2 + 1] = xi;
    __syncthreads();
    float pr = ar, pi = ai;
#pragma unroll
    for (int q = 0; q < 6; ++q) { const float nr = pr * pr - pi * pi, ni = 2.0f * pr * pi; pr = nr; pi = ni; }
    float cr = 0.f, ci = 0.f;
    for (int v = 0; v < wave; ++v) { const float er = Ese[(v * 64 + p) * 2], ei = Ese[(v * 64 + p) * 2 + 1]; const float nr = pr * cr - pi * ci + er, ni = pr * ci + pi * cr + ei; cr = nr; ci = ni; }
    xr = cr; xi = ci;
#pragma unroll 16
    for (int k = 0; k < 64; ++k) {
        const unsigned sv = sp[SGN * k * 128];
        xp[SGN * k * 512] = (bf16_t)f2bf(xr); xp[SGN * k * 512 + 64] = (bf16_t)f2bf(xi);
        const float nr = ar * xr - ai * xi + bf_lo(sv), ni = ar * xi + ai * xr + bf_hi(sv);
        xr = nr; xi = ni;
    }
    __syncthreads();
}
__device__ __forceinline__ void scan_phase(const bf16_t* S, const float* A16, bf16_t* AS, LAS unsigned char* lds, int vcu, int G, int tid) {
    const int lane = tid & 63, wave = __builtin_amdgcn_readfirstlane(tid >> 6);
    LAS float* Ese = (LAS float*)lds;
    for (int it = vcu; it < 256; it += G) {
        const int g = it >> 2, b = (it >> 1) & 1, dir = it & 1, p = lane;
        const float ar = A16[((size_t)(dir * 64 + g) * 64 + p) * 2], ai = A16[((size_t)(dir * 64 + g) * 64 + p) * 2 + 1];
        const int c0 = dir == 0 ? wave * 64 : 511 - wave * 64;
        const unsigned* sp = (const unsigned*)(S + ((size_t)g * 1024 + b * 512 + c0) * 256 + dir * 128) + p;
        bf16_t* xp = AS + ((size_t)g * 1024 + b * 512 + c0) * 512 + 256 + dir * 128 + p;
        if (dir == 0) scan_item<1>(sp, xp, ar, ai, Ese, wave, p); else scan_item<-1>(sp, xp, ar, ai, Ese, wave, p);
    }
}

__device__ __forceinline__ void s5_fill_u(const float* xs, const float* SS, const float* gvec, const float* modp  , bf16_t* AS, int z, int pm, int tid) {
    const int sub = tid & 3, b = pm >> 1, col = 16 * z + 4 * sub;
    const f32x4 a4 = *(const f32x4*)(gvec + col) * (*(const f32x4*)(modp + (size_t)b * MODN + D + col) + 1.0f);
    const f32x4 s4 = *(const f32x4*)(modp + (size_t)b * MODN + col);
#pragma unroll 4
    for (int ps = 0; ps < 32; ++ps) {
        const int tok = 4096 * pm + ps * 128 + (tid >> 2);
        const float rs = pg8::rstd_from_ss(SS, tok);
        const f32x4 h = *(const f32x4*)(xs + (size_t)tok * D + col) * rs * a4 + s4;
        u32x2 w; w.x = pk2(h.x, h.y); w.y = pk2(h.z, h.w);
        *(u32x2*)(AS + ((size_t)z * 1024 + (tok >> 4)) * 512 + (tok & 15) * 16 + 4 * sub) = w;
    }
}

constexpr int LDS_BYTES = 147456;
__global__ void __launch_bounds__(NWAVES * 64, 2) fwd_kernel(Args args_unused) {
    extern __shared__ __attribute__((aligned(16))) unsigned char lds_raw[];
    LAS unsigned char* lds = (LAS unsigned char*)lds_raw;
    const CAS Args* ap0 = (const CAS Args*)__builtin_amdgcn_kernarg_segment_ptr();
    int ph_lo = ap0->ph_lo; const int ph_hi = ap0->ph_hi;
    volatile LAS unsigned* MISC = (volatile LAS unsigned*)(lds + 141312);
    if (threadIdx.x < 64) MISC[threadIdx.x] = 0u;
    __syncthreads();
    XcdBarrier bar; bar.bar = (unsigned*)(ap0->ws + WS_CTL) + CW_BAR; bar.x = 0; bar.st = nullptr;
    if (ap0->sync) bar = xcd_barrier_post((unsigned*)(ap0->ws + WS_CTL) + CW_BAR, MISC + 8);
#define GRID_SYNC() do { if (ap0->sync == 1) xcd_barrier(bar); else if (ap0->sync == 2) cg::this_grid().sync(); } while (0)
    if (ph_lo == 0) {
        const CAS Args* ap = ap0; asm volatile("" : "+s"(ap));
        int tid = threadIdx.x; asm volatile("" : "+v"(tid));
        const int G = gridDim.x, bx = blockIdx.x;
        const int vcu = (G % 8 == 0) ? (bx % 8) * (G / 8) + bx / 8 : bx;
        p0_prologue(ap, lds, vcu, G, tid);
        if (DUP_PH == 0) { GRID_SYNC(); p0_prologue(ap, lds, vcu, G, tid); }
        ph_lo = 1;
        if (ph_lo < ph_hi) GRID_SYNC();
    }
    for (int phx = ph_lo; phx < ph_hi + DUP_LEN; ++phx) {
        const int ph = (DUP_PH > 0 && phx > DUP_HI) ? phx - DUP_LEN : phx;
        const CAS Args* ap = ap0; asm volatile("" : "+s"(ap));
        int tid = threadIdx.x; asm volatile("" : "+v"(tid));
        const int G = gridDim.x, bx = blockIdx.x;
        const int vcu = (G % 8 == 0) ? (bx % 8) * (G / 8) + bx / 8 : bx;
        unsigned char* ws = ap->ws;
        float* MOD = (float*)(ws + WS_MOD);
        bf16_t* XN = (bf16_t*)(ws + WS_XN); bf16_t* ACT = (bf16_t*)(ws + WS_ACT); bf16_t* PP = ACT; bf16_t* AS = ACT;
        bf16_t* SB = (bf16_t*)(ws + WS_S); bf16_t* YB = (bf16_t*)(ws + WS_S + 32 * MiB);
        float* SS = (float*)(ws + WS_SS); float* SW = (float*)(ws + WS_SW);
        LAS float* PX = (LAS float*)(lds + 133120);
        float* xs = ap->out;
        switch (ph) {
        case 1: {
            norm_phase<3>(ap->in[0], ap->in[4], MOD, XN, SS, vcu, G, tid);
            sw_phase(MOD, (const bf16_t*)(ws + WS_WIN), SW, vcu, G, tid);
        } break;
        case 16: norm_phase<2>(xs, ap->in[20], nullptr, xs, nullptr, vcu, G, tid); break;
        case 2: case 6: case 8: case 14: {
            const int lf = ph == 2 ? 0 : ph == 6 ? 1 : ph == 8 ? 2 : 3;
            pg8::Gemm g{XN, (const bf16_t*)(ws + WS_WIN) + (size_t)lf * WIN_ELEMS, D, D, D, 0, 0, 0};
            pg8::StaticOrder S; S.init(M, NW1, G, bx);
            pg8::EpiSwiGLU E{ACT, FFP, SS, SW + (size_t)lf * 2 * NW1};
            pg8::gemm_phase<pg8::EpiSwiGLU, pg8::StaticOrder>(lds, g, S, E, tid);
        } break;
        case 3: case 7: case 9: case 15: case 5: {
            const bool pool = ph == 5;
            const int lf = ph == 3 ? 0 : ph == 7 ? 1 : ph == 9 ? 2 : 3, l = pool ? 0 : (lf >> 1), sub = pool ? 1 : (lf & 1) * 2;
            const int ln = sub == 2 ? l + 1 : l, sn = sub == 2 ? 0 : sub + 1, emit = (ph == 9 || ph == 15) ? 0 : 1, lnc = ln > 1 ? 1 : ln;
            const bf16_t* Ap = pool ? PP : ACT;
            const bf16_t* Bp = pool ? (const bf16_t*)(ws + WS_WPOOL) : (const bf16_t*)(ws + WS_WOUT) + (size_t)lf * WOUT_ELEMS;
            const int lda = pool ? D : FFP, ldb = pool ? 256 : FFP;
            pg8::Gemm g{Ap, Bp, lda, ldb, ldb, pool ? 256 : 0, 0, 0};
            const float* CZ = (const float*)(ws + WS_CONST);
            pg8::EpiResid E{ph == 3 ? ap->in[0] : xs, xs, MOD + (size_t)l * 2 * MODN + sub * 3 * D + 2 * D, pool ? ap->in[8] : CZ, pool ? ap->in[9] : CZ + D,
                            ap->in[4] + (lnc * 3 + sn) * D, MOD + (size_t)lnc * 2 * MODN + sn * 3 * D + D, XN, SS, PX, emit};
            pg8::StaticOrder S; S.init(M, D, G, bx);
            pg8::gemm_phase<pg8::EpiResid, pg8::StaticOrder>(lds, g, S, E, tid);
        } break;
        case 4: pool_phase(XN, SS, PP, vcu, G, tid); break;
        case 10: {
            pg8::Gemm g{AS, (const bf16_t*)(ws + WS_EBT), 512, 256, 256, 0, (size_t)1024 * 512, (size_t)256 * 256};
            pg8::GroupOrder S{256, G, bx};
            { pg8::Unit uu; for (int i = 0; S.next(i, uu); ++i) s5_fill_u(xs, SS, ap->in[4] + (1 * 3 + 1) * D, MOD + (size_t)2 * MODN + 3 * D, AS, uu.z, uu.pm, tid); }
            asm volatile("s_waitcnt vmcnt(0)" ::: "memory"); __syncthreads();
            pg8::EpiS16 E{SB};
            pg8::gemm_phase<pg8::EpiS16, pg8::GroupOrder>(lds, g, S, E, tid);
        } break;
        case 11: scan_phase(SB, (const float*)(ws + WS_A16), AS, lds, vcu, G, tid); break;
        case 12: {
            pg8::Gemm g{AS, (const bf16_t*)(ws + WS_TFBT), 512, 512, 512, 0, (size_t)1024 * 512, (size_t)256 * 512};
            pg8::GroupOrder S{256, G, bx};
            pg8::EpiS5Y E{YB};
            pg8::gemm_phase<pg8::EpiS5Y, pg8::GroupOrder>(lds, g, S, E, tid);
        } break;
        case 13: {
            pg8::Gemm g{YB, (const bf16_t*)(ws + WS_WGLU), D, D, D, 0, 0, 0};
            pg8::StaticOrder S; S.init(M, 2 * D, G, bx);
            pg8::EpiGLU E{xs, xs, MOD + (size_t)2 * MODN + 1 * 3 * D + 2 * D, ap->in[19], ap->in[4] + (1 * 3 + 2) * D, MOD + (size_t)2 * MODN + 2 * 3 * D + D, XN, SS, PX};
            pg8::gemm_phase<pg8::EpiGLU, pg8::StaticOrder>(lds, g, S, E, tid);
        } break;
        default: break;
        }
        if (phx + 1 < ph_hi + DUP_LEN) GRID_SYNC();
    }
}

extern "C" void kernel_launch(void* const* d_in, const int* in_sizes, int n_in, void* d_out, int out_size, void* d_ws, size_t ws_size, hipStream_t stream) {
    static int grid = 0;
    if (grid == 0) {
        if (n_in != 21 || in_sizes[0] != M * D || out_size != M * D || ws_size < WS_END) { fprintf(stderr, "kernel_launch: unexpected shapes (n_in %d, in0 %d, out %d, ws %zu < %zu)\n", n_in, n_in > 0 ? in_sizes[0] : -1, out_size, ws_size, (size_t)WS_END); grid = -1; return; }
        int dev = 0, cus = 0, per_cu = 0;
        if (hipGetDevice(&dev) != hipSuccess || hipDeviceGetAttribute(&cus, hipDeviceAttributeMultiprocessorCount, dev) != hipSuccess) { grid = -1; return; }
        if (hipFuncSetAttribute((const void*)fwd_kernel, hipFuncAttributeMaxDynamicSharedMemorySize, LDS_BYTES) != hipSuccess) { fprintf(stderr, "kernel_launch: hipFuncSetAttribute failed\n"); grid = -1; return; }
        if (hipOccupancyMaxActiveBlocksPerMultiprocessor(&per_cu, (const void*)fwd_kernel, NWAVES * 64, LDS_BYTES) != hipSuccess || per_cu < 1) { fprintf(stderr, "kernel_launch: occupancy query says %d\n", per_cu); per_cu = 1; }
        (void)hipGetLastError();
        grid = cus;
        if (grid > 256) grid = 256;
    }
    if (grid < 0) return;
    Args a{};
    for (int i = 0; i < 21; ++i) a.in[i] = (const float*)d_in[i];
    a.out = (float*)d_out; a.ws = (unsigned char*)d_ws;
#if ONE_LAUNCH
    if (hipMemsetAsync((char*)d_ws + WS_CTL, 0, CTL_ZERO_BYTES, stream) != hipSuccess) { fprintf(stderr, "kernel_launch: memset of the control words failed\n"); return; }
    a.ph_lo = 0; a.ph_hi = NPHASES; a.sync = 1; a.pad = 0;
    void* kargs[] = {&a};
    hipError_t e = hipLaunchCooperativeKernel((const void*)fwd_kernel, dim3(grid), dim3(NWAVES * 64), kargs, LDS_BYTES, stream);
    if (e != hipSuccess) fprintf(stderr, "kernel_launch: cooperative launch failed: %s (grid %d)\n", hipGetErrorString(e), grid);
#else
    for (int ph = 0; ph < NPHASES; ++ph) {
        a.ph_lo = ph; a.ph_hi = ph + 1; a.sync = 0; a.pad = 0;
        hipLaunchKernelGGL(fwd_kernel, dim3(grid), dim3(NWAVES * 64), LDS_BYTES, stream, a);
    }
#endif
}
```

```cpp
#include <hip/hip_runtime.h>
#include <hip/hip_cooperative_groups.h>
#include <cstdio>
#include <cstdint>
namespace cg = cooperative_groups;

#ifndef ONE_LAUNCH
#define ONE_LAUNCH 1
#endif
#ifndef DUP_PH
#define DUP_PH -1
#endif
#ifndef DUP_HI
#define DUP_HI 13
#endif
#define DUP_LEN (DUP_PH > 0 ? (DUP_HI - DUP_PH + 1) : 0)

#define LAS __attribute__((address_space(3)))
typedef unsigned short bf16_t;
typedef short bf16x8 __attribute__((ext_vector_type(8)));
typedef float f32x4 __attribute__((ext_vector_type(4)));
typedef float f32x2 __attribute__((ext_vector_type(2)));
typedef unsigned u32x4 __attribute__((ext_vector_type(4)));
typedef unsigned u32x2 __attribute__((ext_vector_type(2)));

constexpr int BATCH = 2, SEQ = 8192, D = 1024, M = BATCH * SEQ, FF = 2752, FFP = 2816, NW1 = 2 * FFP;
constexpr int MODN = 9216;
constexpr float EPS = 1e-6f;
constexpr int NWAVES = 8;
constexpr int NPHASES = 17;

constexpr size_t MiB = 1u << 20;
constexpr size_t WS_CTL = 0, CTL_ZERO_BYTES = 65536;
constexpr int CW_BAR = 4096;
constexpr size_t WS_MOD = 1 * MiB;
constexpr size_t WS_CONST = 1 * MiB + 512 * 1024;
constexpr size_t WS_SW = 1 * MiB + 640 * 1024;
constexpr size_t WS_A16 = 2 * MiB;
constexpr size_t WS_WPOOL = 3 * MiB;
constexpr size_t WS_SS = 3 * MiB + 512 * 1024;
constexpr size_t WS_WGLU = 4 * MiB;
constexpr size_t WS_EBT = 8 * MiB;
constexpr size_t WS_TFBT = 16 * MiB;
constexpr size_t WS_WIN = 32 * MiB;
constexpr size_t WS_WOUT = 76 * MiB;
constexpr size_t WS_XN = 98 * MiB;
constexpr size_t WS_ACT = 130 * MiB;
constexpr size_t WS_S = 218 * MiB;
constexpr size_t WS_END = 282 * MiB;
constexpr size_t WIN_ELEMS = (size_t)NW1 * D, WOUT_ELEMS = (size_t)D * FFP;

namespace pg8 {
constexpr int BM = 256, BK = 64, HALF = 128, HTB = HALF * BK * 2, STAGE_BYTES = 8 * HTB, NXCD = 8, WGM = 8;
__host__ __device__ __forceinline__ int lds_byte(int r, int c) { const int st = (r >> 4) * 2 + (c >> 5), rr = r & 15, cc = c & 31, ob = rr * 64 + cc * 2; return st * 1024 + (ob ^ (((ob >> 9) & 1) << 5)); }
__host__ __device__ __forceinline__ void stage_rc(int b, int& R, int& C) { const int st = b / 1024, sb = b % 1024, swz = sb ^ (((sb >> 9) & 1) << 5); R = (st >> 1) * 16 + swz / 64; C = (st & 1) * 32 + (swz % 64) / 2; }
__host__ __device__ __forceinline__ int perm32(int rho) { const int n = rho >> 4, i = rho & 15; return 8 * (i >> 2) + 4 * n + (i & 3); }

struct Unit { int pm, pn, z; };
struct Gemm { const bf16_t* A; const bf16_t* Bt; int lda, ldb, K, koffA; size_t zsA, zsB; };

struct StaticOrder {
    int nM, nN, nwg, G, c;
    __device__ __forceinline__ void init(int M_, int N_, int G_, int c_) { nM = M_ / BM; nN = N_ / BM; nwg = nM * nN; G = G_; c = c_; }
    __device__ __forceinline__ bool next(int i, Unit& u) const {
        const long L = (long)i * G + c; if (L >= nwg) return false;
        int wgid = (int)L; { const int q = nwg / NXCD, r = nwg % NXCD, xcd = wgid % NXCD, off = wgid / NXCD; wgid = (xcd < r ? xcd * (q + 1) : r * (q + 1) + (xcd - r) * q) + off; }
        const int nig = WGM * nN, gid = wgid / nig, fm = gid * WGM, gsz = (nM - fm) < WGM ? (nM - fm) : WGM;
        u.pm = fm + ((wgid % nig) % gsz); u.pn = (wgid % nig) / gsz; u.z = 0; return true;
    }
};
struct GroupOrder {
    int n, G, c;
    __device__ __forceinline__ bool next(int i, Unit& u) const { const int L = i * G + c; if (L >= n) return false;
        const int xcd = L & 7, idx = L >> 3, combo = (idx >> 2) * 8 + xcd; u.z = (combo >> 2) * 4 + (idx & 3); u.pm = combo & 3; u.pn = 0; return true; }
};

__device__ __forceinline__ unsigned cvt_pk_bf16(float lo, float hi) { unsigned r; asm volatile("v_cvt_pk_bf16_f32 %0, %1, %2" : "=v"(r) : "v"(lo), "v"(hi)); return r; }
__device__ __forceinline__ float sigmoidf_(float x) { return __builtin_amdgcn_rcpf(1.0f + __builtin_amdgcn_exp2f(-1.4426950408889634f * x)); }
__device__ __forceinline__ float siluf_(float x) { return x * sigmoidf_(x); }
__device__ __forceinline__ float gelu_tanh_(float y) { const float z = 0.7978845608028654f * (y + 0.044715f * y * y * y); return y * sigmoidf_(2.0f * z); }

typedef f32x4 Acc[2][2][4][2];

template <int NB>
__device__ __forceinline__ void ss_publish(const float (&q)[NB][2][4], float* SS, int pm, int slot0, int wr, int wc, int fr, int fq, LAS float* P) {
#pragma unroll
    for (int bj = 0; bj < NB; ++bj)
#pragma unroll
        for (int ai = 0; ai < 2; ++ai)
#pragma unroll
            for (int m = 0; m < 4; ++m) { float v = q[bj][ai][m]; v += __shfl_xor(v, 16); v += __shfl_xor(v, 32);
                if (fq == 0) P[(bj * 256 + ai * HALF + wr * 64 + m * 16 + fr) * 4 + wc] = v; }
    asm volatile("s_waitcnt lgkmcnt(0)" ::: "memory"); __builtin_amdgcn_s_barrier(); asm volatile("" ::: "memory");
    const int tid = (wr * 4 + wc) * 64 + fq * 16 + fr;
    if (tid < NB * 256) { const f32x4 v = *(const LAS f32x4*)(P + tid * 4); SS[(size_t)(pm * BM + (tid & 255)) * 8 + slot0 + (tid >> 8)] = (v.x + v.y) + (v.z + v.w); }
}
__device__ __forceinline__ float rstd_from_ss(const float* SS, int row) {
    const f32x4 a = *(const f32x4*)(SS + (size_t)row * 8), b = *(const f32x4*)(SS + (size_t)row * 8 + 4);
    return 1.0f / sqrtf(((a.x + a.y) + (a.z + a.w) + (b.x + b.y) + (b.z + b.w)) * (1.0f / D) + EPS);
}

struct EpiSwiGLU {
    static constexpr bool PERM = true;
    bf16_t* O; int ldc; const float* SS; const float* SW;
    __device__ __forceinline__ void operator()(const Acc& acc, const Unit& u, int wr, int wc, int fr, int fq) const {
        const int row0 = u.pm * BM + wr * 64 + fr, col0 = u.pn * HALF + wc * 32 + 8 * fq, b = u.pm >> 5;
        const float* swp = SW + (size_t)b * NW1 + u.pn * BM + wc * 32 + 8 * fq;
        const f32x4 sg0 = *(const f32x4*)(swp), sg1 = *(const f32x4*)(swp + 4), su0 = *(const f32x4*)(swp + HALF), su1 = *(const f32x4*)(swp + HALF + 4);
#pragma unroll
        for (int ai = 0; ai < 2; ++ai)
#pragma unroll
            for (int m = 0; m < 4; ++m) {
                const int row = row0 + ai * HALF + m * 16;
                const float rs = rstd_from_ss(SS, row);
                bf16_t* rowp = O + (size_t)row * ldc + col0;
                const f32x4 g0 = acc[ai][0][m][0] * rs + sg0, g1 = acc[ai][0][m][1] * rs + sg1, u0 = acc[ai][1][m][0] * rs + su0, u1 = acc[ai][1][m][1] * rs + su1;
                u32x4 w;
                w.x = cvt_pk_bf16(siluf_(g0[0]) * u0[0], siluf_(g0[1]) * u0[1]); w.y = cvt_pk_bf16(siluf_(g0[2]) * u0[2], siluf_(g0[3]) * u0[3]);
                w.z = cvt_pk_bf16(siluf_(g1[0]) * u1[0], siluf_(g1[1]) * u1[1]); w.w = cvt_pk_bf16(siluf_(g1[2]) * u1[2], siluf_(g1[3]) * u1[3]);
                *(u32x4*)rowp = w;
            }
    }
};
struct EpiResid {
    static constexpr bool PERM = true;
    const float* xin; float* xout; const float* gate; const float* bias; const float* scl; const float* gnext; const float* scnext; bf16_t* XP; float* SS; LAS float* P; int emit;
    __device__ __forceinline__ void operator()(const Acc& acc, const Unit& u, int wr, int wc, int fr, int fq) const {
        const int b = u.pm >> 5, col0 = u.pn * BM + wc * 32 + 8 * fq;
        const size_t off0 = (size_t)(u.pm * BM + wr * 64 + fr) * D + col0;
        float q[2][2][4];
#pragma unroll
        for (int bj = 0; bj < 2; ++bj) {
            const int c = col0 + bj * HALF;
            f32x4 gv[2], bv[2], sv[2], an[2];
#pragma unroll
            for (int n = 0; n < 2; ++n) {
                gv[n] = *(const f32x4*)(gate + (size_t)b * MODN + c + 4 * n); bv[n] = *(const f32x4*)(bias + c + 4 * n); sv[n] = *(const f32x4*)(scl + c + 4 * n);
                an[n] = *(const f32x4*)(gnext + c + 4 * n) * (*(const f32x4*)(scnext + (size_t)b * MODN + c + 4 * n) + 1.0f);
            }
#pragma unroll
            for (int ai = 0; ai < 2; ++ai) {
#pragma unroll
                for (int m = 0; m < 4; ++m) {
                    const size_t ro = off0 + bj * HALF + (size_t)(ai * HALF + m * 16) * D;
                    const f32x4 x0 = *(const f32x4*)(xin + ro), x1 = *(const f32x4*)(xin + ro + 4);
                    const f32x4 o0 = x0 + gv[0] * ((acc[ai][bj][m][0] + bv[0]) * sv[0]), o1 = x1 + gv[1] * ((acc[ai][bj][m][1] + bv[1]) * sv[1]);
                    *(f32x4*)(xout + ro) = o0; *(f32x4*)(xout + ro + 4) = o1;
                    q[bj][ai][m] = ((o0.x * o0.x + o0.y * o0.y) + (o0.z * o0.z + o0.w * o0.w)) + ((o1.x * o1.x + o1.y * o1.y) + (o1.z * o1.z + o1.w * o1.w));
                    if (emit) { const f32x4 h0 = o0 * an[0], h1 = o1 * an[1]; u32x4 w; w.x = cvt_pk_bf16(h0.x, h0.y); w.y = cvt_pk_bf16(h0.z, h0.w); w.z = cvt_pk_bf16(h1.x, h1.y); w.w = cvt_pk_bf16(h1.z, h1.w);
                        *(u32x4*)(XP + ro) = w; }
                }
                asm volatile("" ::: "memory");
            }
        }
        ss_publish<2>(q, SS, u.pm, 2 * u.pn, wr, wc, fr, fq, P);
    }
};
struct EpiGLU {
    static constexpr bool PERM = true;
    const float* xin; float* xout; const float* gate; const float* gb; const float* gnext; const float* scnext; bf16_t* XP; float* SS; LAS float* P;
    __device__ __forceinline__ void operator()(const Acc& acc, const Unit& u, int wr, int wc, int fr, int fq) const {
        const int b = u.pm >> 5, f0 = u.pn * HALF + wc * 32 + 8 * fq;
        const size_t off0 = (size_t)(u.pm * BM + wr * 64 + fr) * D + f0;
        f32x4 gv[2], b1[2], b2[2], an[2];
#pragma unroll
        for (int n = 0; n < 2; ++n) { const int c = f0 + 4 * n; gv[n] = *(const f32x4*)(gate + (size_t)b * MODN + c); b1[n] = *(const f32x4*)(gb + c); b2[n] = *(const f32x4*)(gb + D + c);
            an[n] = *(const f32x4*)(gnext + c) * (*(const f32x4*)(scnext + (size_t)b * MODN + c) + 1.0f); }
        float q[1][2][4];
#pragma unroll
        for (int ai = 0; ai < 2; ++ai) {
#pragma unroll
            for (int m = 0; m < 4; ++m) {
                const size_t ro = off0 + (size_t)(ai * HALF + m * 16) * D;
                f32x4 o[2];
#pragma unroll
                for (int n = 0; n < 2; ++n) {
                    const f32x4 xi = *(const f32x4*)(xin + ro + 4 * n);
                    const f32x4 z1 = acc[ai][0][m][n] + b1[n], z2 = acc[ai][1][m][n] + b2[n];
#pragma unroll
                    for (int e = 0; e < 4; ++e) o[n][e] = xi[e] + gv[n][e] * z1[e] * sigmoidf_(z2[e]);
                    *(f32x4*)(xout + ro + 4 * n) = o[n];
                }
                q[0][ai][m] = ((o[0].x * o[0].x + o[0].y * o[0].y) + (o[0].z * o[0].z + o[0].w * o[0].w)) + ((o[1].x * o[1].x + o[1].y * o[1].y) + (o[1].z * o[1].z + o[1].w * o[1].w));
                const f32x4 h0 = o[0] * an[0], h1 = o[1] * an[1]; u32x4 w; w.x = cvt_pk_bf16(h0.x, h0.y); w.y = cvt_pk_bf16(h0.z, h0.w); w.z = cvt_pk_bf16(h1.x, h1.y); w.w = cvt_pk_bf16(h1.z, h1.w);
                *(u32x4*)(XP + ro) = w;
            }
            asm volatile("" ::: "memory");
        }
        ss_publish<1>(q, SS, u.pm, u.pn, wr, wc, fr, fq, P);
    }
};
struct EpiS16 {
    static constexpr bool PERM = false;
    bf16_t* O;
    __device__ __forceinline__ void operator()(const Acc& acc, const Unit& u, int wr, int wc, int fr, int fq) const {
        bf16_t* base = O + (size_t)u.z * 1024 * 256 + (size_t)(u.pm * BM + wr * 64 + fr) * 256 + wc * 32 + 4 * fq;
#pragma unroll
        for (int ai = 0; ai < 2; ++ai)
#pragma unroll
            for (int m = 0; m < 4; ++m) {
                bf16_t* rowp = base + (size_t)(ai * HALF + m * 16) * 256;
                asm volatile("" : "+v"(rowp));
#pragma unroll
                for (int bj = 0; bj < 2; ++bj)
#pragma unroll
                    for (int n = 0; n < 2; ++n) { const f32x4 v = acc[ai][bj][m][n]; u32x2 w; w.x = cvt_pk_bf16(v[0], v[1]); w.y = cvt_pk_bf16(v[2], v[3]); *(u32x2*)(rowp + bj * HALF + n * 16) = w; }
            }
    }
};
struct EpiS5Y {
    static constexpr bool PERM = false;
    bf16_t* Y;
    __device__ __forceinline__ void operator()(const Acc& acc, const Unit& u, int wr, int wc, int fr, int fq) const {
#pragma unroll
        for (int ai = 0; ai < 2; ++ai)
#pragma unroll
            for (int m = 0; m < 4; ++m) {
                const int r = u.pm * BM + ai * HALF + wr * 64 + m * 16 + fr;
#pragma unroll
                for (int bj = 0; bj < 2; ++bj)
#pragma unroll
                    for (int n = 0; n < 2; ++n) {
                        const int i = 8 * bj + 2 * wc + n;
                        const f32x4 v = acc[ai][bj][m][n];
                        u32x2 w; w.x = cvt_pk_bf16(gelu_tanh_(v[0]), gelu_tanh_(v[1])); w.y = cvt_pk_bf16(gelu_tanh_(v[2]), gelu_tanh_(v[3]));
                        *(u32x2*)(Y + (size_t)(r * 16 + i) * D + u.z * 16 + 4 * fq) = w;
                    }
            }
    }
};

template <class Epi, class Sched>
__device__ __forceinline__ void gemm_phase(LAS unsigned char* lds, const Gemm g, const Sched& S, const Epi& E, const int tid_in) {
    int tid = tid_in; asm volatile("" : "+v"(tid));
    const int wid = __builtin_amdgcn_readfirstlane(tid >> 6), lane = tid & 63, wr = wid >> 2, wc = wid & 3, fr = lane & 15, fq = lane >> 4;
    const int K = g.K, nt = K / BK;
    unsigned voffA[2], voffB[2];
#pragma unroll
    for (int i = 0; i < 2; ++i) { int R, C; stage_rc(tid * 16 + i * 8192, R, C); const int Rb = Epi::PERM ? ((R & ~31) + perm32(R & 31)) : R;
        voffA[i] = (unsigned)(R * g.lda + C) * 2u; voffB[i] = (unsigned)(Rb * g.ldb + C) * 2u; }
    const size_t kstep = (size_t)(BK * 2);
    const size_t hstepA = (size_t)HALF * g.lda * 2, hstepB = (size_t)HALF * g.ldb * 2;
    const unsigned ldsw = (unsigned)wid * 1024u;
    const int aoff = lds_byte(wr * 64 + fr, fq * 8), boff = lds_byte(wc * 32 + fr, fq * 8);
#define PG8_UA(u) ((const char*)g.A + ((size_t)(u).z * g.zsA + (size_t)(u).pm * BM * g.lda + (size_t)(u).pn * g.koffA) * 2)
#define PG8_UB(u) ((const char*)g.Bt + ((size_t)(u).z * g.zsB + (size_t)(u).pn * BM * g.ldb) * 2)
#define PG8_SA(b, h) (((b) * 2 + (h)) * HTB)
#define PG8_SB(b, h) ((4 + (b) * 2 + (h)) * HTB)
#define PG8_STAGE(bufoff, gbase, voff) do { _Pragma("unroll") for (int _i = 0; _i < 2; ++_i) \
        __builtin_amdgcn_global_load_lds((const unsigned*)((const char*)(gbase) + (voff)[_i]), (LAS unsigned*)(lds + (bufoff) + ldsw + _i * 8192), 16, 0, 0); } while (0)
#define PG8_LDA(dst, b, h) do { _Pragma("unroll") for (int m = 0; m < 4; ++m) _Pragma("unroll") for (int k = 0; k < 2; ++k) dst[m][k] = *(const LAS bf16x8*)(lds + PG8_SA(b, h) + aoff + m * 2048 + k * 1024); } while (0)
#define PG8_LDB(dst, b, h) do { _Pragma("unroll") for (int n = 0; n < 2; ++n) _Pragma("unroll") for (int k = 0; k < 2; ++k) dst[n][k] = *(const LAS bf16x8*)(lds + PG8_SB(b, h) + boff + n * 2048 + k * 1024); } while (0)
#define PG8_MMA(ai, bj, At, Bt) do { __builtin_amdgcn_s_setprio(1); _Pragma("unroll") for (int m = 0; m < 4; ++m) _Pragma("unroll") for (int n = 0; n < 2; ++n) _Pragma("unroll") for (int k = 0; k < 2; ++k) \
        acc[ai][bj][m][n] = __builtin_amdgcn_mfma_f32_16x16x32_bf16(Bt[n][k], At[m][k], acc[ai][bj][m][n], 0, 0, 0); __builtin_amdgcn_s_setprio(0); } while (0)
#define PG8_WAIT_V(n) asm volatile("s_waitcnt vmcnt(" #n ")" ::: "memory")
#define PG8_WAIT_L(n) asm volatile("s_waitcnt lgkmcnt(" #n ")" ::: "memory")
#define PG8_BAR __builtin_amdgcn_s_barrier()
#define PG8_SCHED __builtin_amdgcn_sched_barrier(0)
    Unit cur, nxt; int ui = 0;
    if (!S.next(0, cur)) return;
    Acc acc;
    float zero_ = 0.f; asm volatile("" : "+v"(zero_));
#pragma unroll
    for (int a = 0; a < 2; ++a)
#pragma unroll
        for (int b = 0; b < 2; ++b)
#pragma unroll
            for (int m = 0; m < 4; ++m)
#pragma unroll
                for (int n = 0; n < 2; ++n) acc[a][b][m][n] = (f32x4){zero_, zero_, zero_, zero_};
    bf16x8 At[4][2], B0[2][2], B1[2][2];
    const char* cA = PG8_UA(cur); const char* cB = PG8_UB(cur);
    PG8_STAGE(PG8_SB(0, 0), cB, voffB); PG8_STAGE(PG8_SB(0, 1), cB + hstepB, voffB); PG8_STAGE(PG8_SA(0, 0), cA, voffA); PG8_STAGE(PG8_SA(0, 1), cA + hstepA, voffA);
    if (wr == 1) PG8_BAR;
    PG8_WAIT_V(2); PG8_BAR;
    PG8_STAGE(PG8_SB(1, 0), cB + kstep, voffB); PG8_STAGE(PG8_SA(1, 0), cA + kstep, voffA); PG8_STAGE(PG8_SB(1, 1), cB + hstepB + kstep, voffB);
    PG8_WAIT_V(6); PG8_BAR;
    for (;;) {
        const bool has_next = S.next(ui + 1, nxt);
        const char* nA = has_next ? PG8_UA(nxt) : cA; const char* nB = has_next ? PG8_UB(nxt) : cB;
#pragma nounroll
        for (int t = 0; t < nt; t += 2) {
            const bool last = (t == nt - 2);
            const char* a1 = cA + (size_t)(t + 1) * kstep;
            const char* a2 = last ? nA : cA + (size_t)(t + 2) * kstep; const char* b2 = last ? nB : cB + (size_t)(t + 2) * kstep;
            const char* a3 = a2 + kstep; const char* b3 = b2 + kstep;
            PG8_LDB(B0, 0, 0); PG8_LDB(B1, 0, 1); PG8_SCHED; PG8_LDA(At, 0, 0); PG8_STAGE(PG8_SA(1, 1), a1 + hstepA, voffA);
            PG8_WAIT_V(8); PG8_WAIT_L(0); PG8_BAR; PG8_MMA(0, 0, At, B0); PG8_MMA(0, 1, At, B1); PG8_BAR; PG8_SCHED;
            PG8_LDA(At, 0, 1); PG8_STAGE(PG8_SB(0, 0), b2, voffB); PG8_STAGE(PG8_SB(0, 1), b2 + hstepB, voffB); PG8_STAGE(PG8_SA(0, 0), a2, voffA);
            PG8_WAIT_V(8); PG8_WAIT_L(0); PG8_BAR; PG8_MMA(1, 0, At, B0); PG8_MMA(1, 1, At, B1); PG8_BAR; PG8_SCHED;
            PG8_LDB(B0, 1, 0); PG8_LDB(B1, 1, 1); PG8_SCHED; PG8_LDA(At, 1, 0); PG8_STAGE(PG8_SA(0, 1), a2 + hstepA, voffA);
            PG8_WAIT_V(8); PG8_WAIT_L(0); PG8_BAR; PG8_MMA(0, 0, At, B0); PG8_MMA(0, 1, At, B1); PG8_BAR; PG8_SCHED;
            PG8_LDA(At, 1, 1); PG8_STAGE(PG8_SB(1, 0), b3, voffB); PG8_STAGE(PG8_SB(1, 1), b3 + hstepB, voffB); PG8_STAGE(PG8_SA(1, 0), a3, voffA);
            PG8_WAIT_V(8); PG8_WAIT_L(0); PG8_BAR; PG8_MMA(1, 0, At, B0); PG8_MMA(1, 1, At, B1); PG8_BAR; PG8_SCHED;
        }
        if (wr == 0) PG8_BAR;
        { int fr2 = fr, fq2 = fq; asm volatile("" : "+v"(fr2), "+v"(fq2)); E(acc, cur, wr, wc, fr2, fq2); }
        if (!has_next) break;
#pragma unroll
        for (int a = 0; a < 2; ++a)
#pragma unroll
            for (int b = 0; b < 2; ++b)
#pragma unroll
                for (int m = 0; m < 4; ++m)
#pragma unroll
                    for (int n = 0; n < 2; ++n) acc[a][b][m][n] = (f32x4){zero_, zero_, zero_, zero_};
        cur = nxt; cA = nA; cB = nB; ++ui;
        if (wr == 1) PG8_BAR;
    }
    PG8_WAIT_V(0);
    PG8_BAR;
#undef PG8_UA
#undef PG8_UB
#undef PG8_SA
#undef PG8_SB
#undef PG8_STAGE
#undef PG8_LDA
#undef PG8_LDB
#undef PG8_MMA
#undef PG8_WAIT_V
#undef PG8_WAIT_L
#undef PG8_BAR
#undef PG8_SCHED
}
}

#define LDS_WAIT() asm volatile("s_waitcnt lgkmcnt(0)" ::: "memory")
__device__ __forceinline__ unsigned f2bf(float f) { unsigned u = __builtin_bit_cast(unsigned, f); return (u + 0x7fffu + ((u >> 16) & 1u)) >> 16; }
__device__ __forceinline__ unsigned pk2(float lo, float hi) { return f2bf(lo) | (f2bf(hi) << 16); }
__device__ __forceinline__ float bf_lo(unsigned w) { return __builtin_bit_cast(float, w << 16); }
__device__ __forceinline__ float bf_hi(unsigned w) { return __builtin_bit_cast(float, w & 0xffff0000u); }
__device__ __forceinline__ float wave_sum(float v) {
#define WS_STEP(k) v += __builtin_bit_cast(float, __builtin_amdgcn_ds_swizzle(__builtin_bit_cast(int, v), 0x1f | ((k) << 10)))
    WS_STEP(1); WS_STEP(2); WS_STEP(4); WS_STEP(8); WS_STEP(16);
#undef WS_STEP
    const int iv = __builtin_bit_cast(int, v);
    return __builtin_bit_cast(float, __builtin_amdgcn_readlane(iv, 0)) + __builtin_bit_cast(float, __builtin_amdgcn_readlane(iv, 32));
}

typedef __attribute__((address_space(1))) unsigned gu32;
#define XB_TMO      128
#define XB_XCNT(j)  (256  + 64 * (j))
#define XB_XSUB(j)  (1280 + 64 * (j))
#define XB_XGEN(j)  (2304 + 64 * (j))
#define XB_TOP      3328
#define XB_TOPGEN   3392
#define XCD_BAR_WORDS 3456
#define XB_SPIN_CAP (1u << 18)

__device__ __forceinline__ unsigned xb_ld(unsigned* p)              { return __hip_atomic_load(p, __ATOMIC_RELAXED, __HIP_MEMORY_SCOPE_AGENT); }
__device__ __forceinline__ unsigned xb_add(unsigned* p, unsigned v) { return __hip_atomic_fetch_add(p, v, __ATOMIC_RELAXED, __HIP_MEMORY_SCOPE_AGENT); }
__device__ __forceinline__ unsigned xb_xcc_id() { return (unsigned)__builtin_amdgcn_s_getreg((3 << 11) | 20) & 0xFu; }
#define XB_SPIN(cond, bar) do { unsigned _sp = 0; while (cond) { __builtin_amdgcn_s_sleep(1); \
    if ((++_sp & 255u) == 0u) { if (xb_ld(&(bar)[XB_TMO])) break; if (_sp > XB_SPIN_CAP) { atomicAdd(&(bar)[XB_TMO], 1u); break; } } } } while (0)

struct XcdBarrier {
    unsigned* bar; unsigned x;
    volatile LAS unsigned* st;
};

__device__ __forceinline__ XcdBarrier xcd_barrier_post(unsigned* bar, volatile LAS unsigned* st) {
    XcdBarrier b; b.bar = bar; b.x = xb_xcc_id(); b.st = st;
    if (threadIdx.x == 0) (void)xb_add(&bar[XB_XCNT(b.x)], 1u);
    return b;
}
__device__ __forceinline__ void xcd_barrier_complete(unsigned* bar, unsigned x, unsigned& nloc, unsigned& nx) {
    const unsigned G = gridDim.x * gridDim.y * gridDim.z;
    unsigned sum, cnt, mine, sp = 0u;
    for (;;) {
        sum = 0u; cnt = 0u; mine = 0u;
#pragma unroll
        for (unsigned j = 0; j < 16; ++j) { const unsigned c = xb_ld(&bar[XB_XCNT(j)]); sum += c; cnt += (c > 0u) ? 1u : 0u; mine = (j == x) ? c : mine; }
        if (sum == G) break;
        __builtin_amdgcn_s_sleep(1);
        if ((++sp & 255u) == 0u) { if (xb_ld(&bar[XB_TMO])) break; if (sp > XB_SPIN_CAP) { atomicAdd(&bar[XB_TMO], 1u); break; } }
    }
    nloc = mine > 0u ? mine : 1u; nx = cnt > 0u ? cnt : 1u;
}

__device__ __forceinline__ void xcd_barrier(const XcdBarrier& b) {
    asm volatile("s_waitcnt vmcnt(0)" ::: "memory");
    __syncthreads();
    if (threadIdx.x == 0) {
        unsigned* bar = b.bar;
        __builtin_amdgcn_s_waitcnt(0);
        unsigned nloc = b.st[0], nx = b.st[1];
        if (nloc == 0u) { xcd_barrier_complete(bar, b.x, nloc, nx); b.st[0] = nloc; b.st[1] = nx; }
        const unsigned old = xb_add(&bar[XB_XSUB(b.x)], 1u);
        const unsigned gen = old / nloc;
        if (old + 1u == (gen + 1u) * nloc) {
            __builtin_amdgcn_fence(__ATOMIC_RELEASE, "agent");
            asm volatile("s_waitcnt vmcnt(0)" ::: "memory");
            const unsigned og = xb_add(&bar[XB_TOP], 1u);
            const unsigned tg = og / nx;
            if (og + 1u == (tg + 1u) * nx) xb_add(&bar[XB_TOPGEN], 1u);
            else XB_SPIN(xb_ld(&bar[XB_TOPGEN]) == tg, bar);
            __builtin_amdgcn_fence(__ATOMIC_ACQUIRE, "agent");
            xb_add(&bar[XB_XGEN(b.x)], 1u);
            asm volatile("s_waitcnt vmcnt(0)" ::: "memory");
        } else {
            XB_SPIN(xb_ld(&bar[XB_XGEN(b.x)]) == gen, bar);
            __builtin_amdgcn_fence(__ATOMIC_ACQUIRE, "agent");
            asm volatile("s_waitcnt vmcnt(0)" ::: "memory");
        }
    }
    __syncthreads();
}


struct Args {
    const float* in[21]; float* out; unsigned char* ws; int ph_lo, ph_hi, sync, pad;
};

__device__ __forceinline__ void p0_transpose_item(const float* W, int ldw, bf16_t* WT, int ldt, int dest_row0, int k0, int n0, LAS float* scr, int lane) {
#pragma unroll 16
    for (int i = 0; i < 32; ++i) { const int kk = 2 * i + (lane >> 5); scr[kk * 33 + (lane & 31)] = W[(size_t)(k0 + kk) * ldw + n0 + (lane & 31)]; }
    LDS_WAIT(); asm volatile("" ::: "memory");
    const int c = lane & 7;
#pragma unroll
    for (int j = 0; j < 4; ++j) { const int n = (lane >> 3) + 8 * j; const LAS float* s = scr + (8 * c) * 33 + n;
        u32x4 o; o.x = pk2(s[0 * 33], s[1 * 33]); o.y = pk2(s[2 * 33], s[3 * 33]); o.z = pk2(s[4 * 33], s[5 * 33]); o.w = pk2(s[6 * 33], s[7 * 33]);
        *(u32x4*)(WT + (size_t)(dest_row0 + n) * ldt + k0 + 8 * c) = o; }
    LDS_WAIT(); asm volatile("" ::: "memory");
}

__device__ __forceinline__ int il128(int f) { return ((f >> 7) << 8) + (f & 127); }

#define CAS __attribute__((address_space(4)))
__device__ __forceinline__ void p0_prologue(const CAS Args* ap, LAS unsigned char* lds, int vcu, int G, int tid) {
    const CAS Args& a = *ap;
    const int lane = tid & 63, wave = __builtin_amdgcn_readfirstlane(tid >> 6);
    unsigned char* ws = a.ws;
    {
        LAS float* cnd = (LAS float*)lds;
        LAS float* red = (LAS float*)(lds + 8192);
        if (vcu < 144) {
            const float* c = a.in[1];
            for (int i = tid; i < 2 * D; i += 512) { const float v = c[i]; cnd[i] = v / (1.0f + __expf(-v)); }
        }
        __syncthreads();
        for (int it = vcu; it < 144; it += G) {
            const int l = it / 72, ch = it % 72;
            const float* w = a.in[2] + (size_t)l * D * MODN + (size_t)(wave * 128) * MODN + ch * 128 + 2 * lane;
            f32x2 a0 = {0.f, 0.f}, a1 = {0.f, 0.f};
#pragma unroll 16
            for (int k = 0; k < 128; ++k) { const f32x2 wv = *(const f32x2*)(w + (size_t)k * MODN); const float c0 = cnd[wave * 128 + k], c1 = cnd[D + wave * 128 + k]; a0 += wv * c0; a1 += wv * c1; }
            red[(wave * 2 + 0) * 128 + 2 * lane] = a0.x; red[(wave * 2 + 0) * 128 + 2 * lane + 1] = a0.y;
            red[(wave * 2 + 1) * 128 + 2 * lane] = a1.x; red[(wave * 2 + 1) * 128 + 2 * lane + 1] = a1.y;
            __syncthreads();
            if (tid < 256) { const int b = tid >> 7, col = tid & 127; float s = a.in[3][l * MODN + ch * 128 + col];
#pragma unroll
                for (int w8 = 0; w8 < 8; ++w8) s += red[(w8 * 2 + b) * 128 + col];
                ((float*)(ws + WS_MOD))[(l * 2 + b) * MODN + ch * 128 + col] = s; }
            __syncthreads();
        }
    }
    if (vcu == 0) { float* cz = (float*)(ws + WS_CONST); for (int i = tid; i < 2 * D; i += 512) cz[i] = i < D ? 0.0f : 0.5f; }
    {
        LAS float* Wre = (LAS float*)lds;
        LAS float* Wim = Wre + 2048;
        LAS float* Cre = Wim + 2048;
        LAS float* Cim = Cre + 2080;
        LAS float* Kl = Cim + 2080;
        bf16_t* EBT = (bf16_t*)(ws + WS_EBT); bf16_t* TF = (bf16_t*)(ws + WS_TFBT); float* A16 = (float*)(ws + WS_A16);
        for (int it = vcu; it < 1024; it += G) {
            const int g = it >> 4, tau = it & 15;
            {
                const int dir = tid >> 8, hq = (tid >> 6) & 3, p = tid & 63, dg = dir * 64 + g;
                const float dt = expf(a.in[12][dg]);
                const float lr = a.in[10][dg * 64 + p], li = a.in[11][dg * 64 + p];
                const float xr = lr * dt, yi = li * dt;
                float sy, cy; sincosf(yi, &sy, &cy);
                const float mag = expf(xr), ar = mag * cy, ai = mag * sy;
                const float sh = sinf(0.5f * yi);
                const float arm1 = expm1f(xr) * cy - 2.0f * sh * sh;
                const float den = lr * lr + li * li;
                const float fr_ = (arm1 * lr + ai * li) / den, fi_ = (ai * lr - arm1 * li) / den;
                float st, ct; sincosf((float)tau * yi, &st, &ct);
                const float magt = expf((float)tau * xr), atr = magt * ct, ati = magt * st;
                const float a1r = atr * ar - ati * ai, a1i = atr * ai + ati * ar;
                const f32x4 br = *(const f32x4*)(a.in[13] + ((size_t)dg * 64 + p) * 16 + 4 * hq), bi = *(const f32x4*)(a.in[14] + ((size_t)dg * 64 + p) * 16 + 4 * hq);
                float wr4[4], wi4[4];
#pragma unroll
                for (int e = 0; e < 4; ++e) { const float bbr = fr_ * br[e] - fi_ * bi[e], bbi = fr_ * bi[e] + fi_ * br[e];
                    wr4[e] = atr * bbr - ati * bbi; wi4[e] = atr * bbi + ati * bbr;
                    Wre[(dir * 64 + p) * 16 + 4 * hq + e] = wr4[e]; Wim[(dir * 64 + p) * 16 + 4 * hq + e] = wi4[e]; }
                const int j = dir == 0 ? 15 - tau : tau;
                u32x2 er, ei; er.x = pk2(wr4[0], wr4[1]); er.y = pk2(wr4[2], wr4[3]); ei.x = pk2(wi4[0], wi4[1]); ei.y = pk2(wi4[2], wi4[3]);
                *(u32x2*)(EBT + ((size_t)g * 256 + dir * 128 + 2 * p) * 256 + j * 16 + 4 * hq) = er;
                *(u32x2*)(EBT + ((size_t)g * 256 + dir * 128 + 2 * p + 1) * 256 + j * 16 + 4 * hq) = ei;
                const int irow = dir == 0 ? tau : 15 - tau;
#pragma unroll
                for (int e = 0; e < 4; ++e) { const int hp = 4 * hq + e;
                    const float cr = a.in[15][((size_t)dg * 16 + hp) * 64 + p], ci = a.in[16][((size_t)dg * 16 + hp) * 64 + p];
                    Cre[(dir * 16 + hp) * 65 + p] = cr; Cim[(dir * 16 + hp) * 65 + p] = ci;
                    const float car = cr * a1r - ci * a1i, cai = cr * a1i + ci * a1r;
                    bf16_t* dst = TF + ((size_t)g * 256 + irow * 16 + hp) * 512 + 256 + dir * 128 + p;
                    dst[0] = (bf16_t)f2bf(car); dst[64] = (bf16_t)f2bf(-cai); }
                if (tau == 15 && hq == 0) { A16[((size_t)dg * 64 + p) * 2] = a1r; A16[((size_t)dg * 64 + p) * 2 + 1] = a1i; }
            }
            __syncthreads();
            {
                const int dir = tid >> 8, hp = (tid >> 4) & 15, h = tid & 15;
                float k = 0.f;
#pragma unroll 8
                for (int p = 0; p < 64; ++p) k += Cre[(dir * 16 + hp) * 65 + p] * Wre[(dir * 64 + p) * 16 + h] - Cim[(dir * 16 + hp) * 65 + p] * Wim[(dir * 64 + p) * 16 + h];
                if (tau > 0) {
                    for (int i = 0; i < 16 - tau; ++i) { const int ii = dir == 0 ? i + tau : i, jj = dir == 0 ? i : i + tau;
                        TF[((size_t)g * 256 + ii * 16 + hp) * 512 + jj * 16 + h] = (bf16_t)f2bf(k); }
                } else {
                    Kl[dir * 256 + hp * 16 + h] = k;
                    __syncthreads();
                    if (dir == 0) { const float v = Kl[hp * 16 + h] + Kl[256 + hp * 16 + h] + (h == hp ? a.in[17][g * 16 + h] : 0.f);
                        for (int i = 0; i < 16; ++i) TF[((size_t)g * 256 + i * 16 + hp) * 512 + i * 16 + h] = (bf16_t)f2bf(v); }
                }
            }
            __syncthreads();
        }
    }
    {
        LAS float* scr = (LAS float*)(lds + wave * 16384);
        const int gw = vcu * NWAVES + wave, NGW = G * NWAVES;
        constexpr int I_IN = 16 * 172, I_OUT = 43 * 32, I_POOL = 4 * 8, I_GLU = 16 * 64, I_Z1 = 128, I_Z2 = 128;
        constexpr int NITEMS = 4 * I_IN + 4 * I_OUT + 4 * I_POOL + I_GLU + 4 * I_Z1 + 4 * I_Z2;
        bf16_t* WIN = (bf16_t*)(ws + WS_WIN); bf16_t* WOUT = (bf16_t*)(ws + WS_WOUT); bf16_t* WPOOL = (bf16_t*)(ws + WS_WPOOL); bf16_t* WGLU = (bf16_t*)(ws + WS_WGLU);
        const int nlate = G > 144 ? G - 144 : 0, RES = nlate * NWAVES * 6 < NITEMS ? nlate * NWAVES * 6 : 0;
        const int nloop = (RES > 0 && vcu >= 144) ? 2 : 1;
        for (int lp = 0; lp < nloop; ++lp) {
        const bool head = (nloop == 2 && lp == 0);
        const int i0 = head ? (vcu - 144) * NWAVES + wave : RES + gw, istep = head ? nlate * NWAVES : NGW, iend = head ? RES : NITEMS;
        for (int it = i0; it < iend; it += istep) {
            int r = it;
            if (r < 4 * I_IN) { const int lf = r / I_IN, rr = r % I_IN, kb = rr / 172, nb = rr % 172, n0 = 32 * nb;
                const int dest = n0 < FF ? il128(n0) : il128(n0 - FF) + 128;
                p0_transpose_item(a.in[5] + (size_t)lf * D * 2 * FF, 2 * FF, WIN + (size_t)lf * WIN_ELEMS, D, dest, 64 * kb, n0, scr, lane); continue; }
            r -= 4 * I_IN;
            if (r < 4 * I_OUT) { const int lf = r / I_OUT, rr = r % I_OUT, kb = rr / 32, nb = rr % 32;
                p0_transpose_item(a.in[6] + (size_t)lf * FF * D, D, WOUT + (size_t)lf * WOUT_ELEMS, FFP, 32 * nb, 64 * kb, 32 * nb, scr, lane); continue; }
            r -= 4 * I_OUT;
            if (r < 4 * I_POOL) { const int gi = r / I_POOL, rr = r % I_POOL, kb = rr / 8, nb = rr % 8;
                p0_transpose_item(a.in[7] + (size_t)gi * 65536, 256, WPOOL, 256, gi * 256 + 32 * nb, 64 * kb, 32 * nb, scr, lane); continue; }
            r -= 4 * I_POOL;
            if (r < I_GLU) { const int kb = r / 64, nb = r % 64, n0 = 32 * nb;
                const int dest = n0 < D ? il128(n0) : il128(n0 - D) + 128;
                p0_transpose_item(a.in[18], 2 * D, WGLU, D, dest, 64 * kb, n0, scr, lane); continue; }
            r -= I_GLU;
            if (r < 4 * I_Z1) { const int lf = r / I_Z1, rr = r % I_Z1;
                const int row = 21 * 256 + (rr < 64 ? 64 + rr : 192 + (rr - 64));
                u32x4* p = (u32x4*)(WIN + (size_t)lf * WIN_ELEMS + (size_t)row * D);
                p[lane] = (u32x4){0u, 0u, 0u, 0u}; p[64 + lane] = (u32x4){0u, 0u, 0u, 0u}; continue; }
            r -= 4 * I_Z1;
            { const int lf = r / I_Z2, rr = r % I_Z2;
                const int row = rr * 8 + (lane >> 3);
                *(u32x4*)(WOUT + (size_t)lf * WOUT_ELEMS + (size_t)row * FFP + FF + 8 * (lane & 7)) = (u32x4){0u, 0u, 0u, 0u}; }
        }
        }
    }
}

template <int MODE>
__device__ __forceinline__ void norm_phase(const float* xin, const float* gvec, const float* modp  , void* outp, float* SS, int vcu, int G, int tid) {
    const int lane = tid & 63, wave = __builtin_amdgcn_readfirstlane(tid >> 6);
    const int gw = vcu * NWAVES + wave, NGW = G * NWAVES;
    for (int rb = gw; rb < M / 8; rb += NGW) {
        const int b = rb >> 10;
        f32x4 av[4], sv[4];
#pragma unroll
        for (int j = 0; j < 4; ++j) {
            const int col = 256 * j + 4 * lane;
            const f32x4 gg = *(const f32x4*)(gvec + col);
            if (MODE == 2) { av[j] = gg; sv[j] = (f32x4){0.f, 0.f, 0.f, 0.f}; }
            else { const f32x4 sc = *(const f32x4*)(modp + (size_t)b * MODN + D + col); sv[j] = *(const f32x4*)(modp + (size_t)b * MODN + col); av[j] = gg * (sc + 1.0f); }
        }
#pragma unroll 2
        for (int r = 0; r < 8; ++r) {
            const int row = rb * 8 + r;
            const f32x4* xr = (const f32x4*)(xin + (size_t)row * D) + lane;
            f32x4 v[4]; float s = 0.f;
#pragma unroll
            for (int j = 0; j < 4; ++j) { v[j] = xr[64 * j]; s += (v[j].x * v[j].x + v[j].y * v[j].y) + (v[j].z * v[j].z + v[j].w * v[j].w); }
            const float ssum = wave_sum(s);
            const float rstd = 1.0f / sqrtf(ssum * (1.0f / D) + EPS);
            if (MODE == 3) { if (lane < 2) *(f32x4*)(SS + (size_t)row * 8 + 4 * lane) = (f32x4){lane == 0 ? ssum : 0.f, 0.f, 0.f, 0.f}; }
#pragma unroll
            for (int j = 0; j < 4; ++j) {
                if (MODE == 2) { const f32x4 h = v[j] * rstd * av[j]; ((f32x4*)((float*)outp + (size_t)row * D))[64 * j + lane] = h; }
                else if (MODE == 3) { const f32x4 h = v[j] * av[j]; u32x2 w; w.x = pk2(h.x, h.y); w.y = pk2(h.z, h.w); *(u32x2*)((bf16_t*)outp + (size_t)row * D + 256 * j + 4 * lane) = w; }
                else {
                    const f32x4 h = v[j] * rstd * av[j] + sv[j];
                    u32x2 w; w.x = pk2(h.x, h.y); w.y = pk2(h.z, h.w);
                    const int gi = 16 * j + (lane >> 2); *(u32x2*)((bf16_t*)outp + ((size_t)gi * 1024 + (row >> 4)) * 512 + (row & 15) * 16 + 4 * (lane & 3)) = w;
                }
            }
        }
    }
}

__device__ __forceinline__ void sw_phase(const float* MOD, const bf16_t* WIN, float* SW, int vcu, int G, int tid) {
    const int lane = tid & 63, wave = __builtin_amdgcn_readfirstlane(tid >> 6);
    const int gw = vcu * NWAVES + wave, NGW = G * NWAVES;
    for (int it = gw; it < 4 * 512; it += NGW) {
        const int lf = it & 3, s0 = it >> 2, l = lf >> 1, sub = (lf & 1) * 2;
        f32x4 sh[2][4];
#pragma unroll
        for (int b = 0; b < 2; ++b) { const float* sp = MOD + (size_t)(l * 2 + b) * MODN + sub * 3 * D;
            sh[b][0] = *(const f32x4*)(sp + 8 * lane); sh[b][1] = *(const f32x4*)(sp + 8 * lane + 4); sh[b][2] = *(const f32x4*)(sp + 512 + 8 * lane); sh[b][3] = *(const f32x4*)(sp + 512 + 8 * lane + 4); }
        const bf16_t* wbase = WIN + (size_t)lf * WIN_ELEMS + 8 * lane;
        u32x4 w0[11], w1[11];
#pragma unroll
        for (int i = 0; i < 11; ++i) { const bf16_t* wp = wbase + (size_t)(s0 + 512 * i) * D; w0[i] = *(const u32x4*)wp; w1[i] = *(const u32x4*)(wp + 512); }
#pragma unroll
        for (int i = 0; i < 11; ++i) {
            const f32x4 f0 = {bf_lo(w0[i].x), bf_hi(w0[i].x), bf_lo(w0[i].y), bf_hi(w0[i].y)}, f1 = {bf_lo(w0[i].z), bf_hi(w0[i].z), bf_lo(w0[i].w), bf_hi(w0[i].w)};
            const f32x4 f2 = {bf_lo(w1[i].x), bf_hi(w1[i].x), bf_lo(w1[i].y), bf_hi(w1[i].y)}, f3 = {bf_lo(w1[i].z), bf_hi(w1[i].z), bf_lo(w1[i].w), bf_hi(w1[i].w)};
            float s[2];
#pragma unroll
            for (int b = 0; b < 2; ++b) { const f32x4 t = f0 * sh[b][0] + f1 * sh[b][1] + f2 * sh[b][2] + f3 * sh[b][3]; s[b] = wave_sum((t.x + t.y) + (t.z + t.w)); }
            if (lane < 2) SW[(size_t)(lf * 2 + lane) * NW1 + s0 + 512 * i] = lane == 0 ? s[0] : s[1];
        }
    }
}

__device__ __forceinline__ void pool_acc(float (&s)[8], const bf16_t* p, float f) {
    const u32x4 w = *(const u32x4*)p;
    s[0] += f * bf_lo(w.x); s[1] += f * bf_hi(w.x); s[2] += f * bf_lo(w.y); s[3] += f * bf_hi(w.y); s[4] += f * bf_lo(w.z); s[5] += f * bf_hi(w.z); s[6] += f * bf_lo(w.w); s[7] += f * bf_hi(w.w);
}
__device__ __forceinline__ void pool_phase(const bf16_t* XP, const float* SS, bf16_t* PP, int vcu, int G, int tid) {
    const int lane = tid & 63, wave = __builtin_amdgcn_readfirstlane(tid >> 6);
    const int gw = vcu * NWAVES + wave, NGW = G * NWAVES;
    for (int rb = gw; rb < M / 8; rb += NGW) {
        const int base = rb * 8, b = base >> 13, t0 = base & (SEQ - 1);
        float rl = 0.f;
        { const int tq = t0 - 8 + lane; if (lane < 23 && tq >= 0 && tq < SEQ) rl = pg8::rstd_from_ss(SS, b * SEQ + tq); }
        const bf16_t* xb = XP + (size_t)b * SEQ * D;
#pragma unroll
        for (int jj = 0; jj < 2; ++jj) {
            const int col = 512 * jj + 8 * lane, grp = col >> 8, win = 2 << grp, left = win >> 1, right = win - 1 - left;
            float s[8] = {0.f, 0.f, 0.f, 0.f, 0.f, 0.f, 0.f, 0.f};
            const int rli = __builtin_bit_cast(int, rl);
            const int Lmax = jj == 0 ? 2 : 8, Rmax = jj == 0 ? 1 : 7;
            for (int d = -Lmax; d <= Rmax; ++d) { const int q = t0 + d; if (q < 0 || q >= SEQ) continue;
                const float rq = __builtin_bit_cast(float, __builtin_amdgcn_readlane(rli, d + 8));
                pool_acc(s, xb + (size_t)q * D + col, (d >= -left && d <= right) ? rq : 0.f); }
            for (int r = 0; r < 8; ++r) {
                const int t = t0 + r;
                const int lo = max(t - left, 0), hi = min(t + right, SEQ - 1);
                const float inv = 1.0f / (float)(hi - lo + 1);
                const float rt = __builtin_bit_cast(float, __builtin_amdgcn_readlane(rli, r + 8));
                const u32x4 w = *(const u32x4*)(xb + (size_t)t * D + col);
                u32x4 o;
                o.x = pk2(s[0] * inv - rt * bf_lo(w.x), s[1] * inv - rt * bf_hi(w.x)); o.y = pk2(s[2] * inv - rt * bf_lo(w.y), s[3] * inv - rt * bf_hi(w.y));
                o.z = pk2(s[4] * inv - rt * bf_lo(w.z), s[5] * inv - rt * bf_hi(w.z)); o.w = pk2(s[6] * inv - rt * bf_lo(w.w), s[7] * inv - rt * bf_hi(w.w));
                *(u32x4*)(PP + (size_t)(base + r) * D + col) = o;
                const int qa = t + 1 + right, qs = t - left;
                const float fa = __shfl(rl, qa - t0 + 8), fs = __shfl(rl, qs - t0 + 8);
                pool_acc(s, xb + (size_t)min(qa, SEQ - 1) * D + col, qa < SEQ ? fa : 0.f);
                pool_acc(s, xb + (size_t)max(qs, 0) * D + col, qs >= 0 ? -fs : 0.f);
            }
        }
    }
}

template <int SGN>
__device__ __forceinline__ void scan_item(const unsigned* sp  , bf16_t* xp  , float ar, float ai, LAS float* Ese, int wave, int p) {
    float xr = 0.f, xi = 0.f;
#pragma unroll 16
    for (int k = 0; k < 64; ++k) { const unsigned sv = sp[SGN * k * 128]; const float nr = ar * xr - ai * xi + bf_lo(sv), ni = ar * xi + ai * xr + bf_hi(sv); xr = nr; xi = ni; }
    Ese[(wave * 64 + p) * 2] = xr; Ese[(wave * 64 + p) * 2 + 1] = xi;
    __syncthreads();
    float pr = ar, pi = ai;
#pragma unroll
    for (int q = 0; q < 6; ++q) { const float nr = pr * pr - pi * pi, ni = 2.0f * pr * pi; pr = nr; pi = ni; }
    float cr = 0.f, ci = 0.f;
    for (int v = 0; v < wave; ++v) { const float er = Ese[(v * 64 + p) * 2], ei = Ese[(v * 64 + p) * 2 + 1]; const float nr = pr * cr - pi * ci + er, ni = pr * ci + pi * cr + ei; cr = nr; ci = ni; }
    xr = cr; xi = ci;
#pragma unroll 16
    for (int k = 0; k < 64; ++k) {
        const unsigned sv = sp[SGN * k * 128];
        xp[SGN * k * 512] = (bf16_t)f2bf(xr); xp[SGN * k * 512 + 64] = (bf16_t)f2bf(xi);
        const float nr = ar * xr - ai * xi + bf_lo(sv), ni = ar * xi + ai * xr + bf_hi(sv);
        xr = nr; xi = ni;
    }
    __syncthreads();
}
__device__ __forceinline__ void scan_phase(const bf16_t* S, const float* A16, bf16_t* AS, LAS unsigned char* lds, int vcu, int G, int tid) {
    const int lane = tid & 63, wave = __builtin_amdgcn_readfirstlane(tid >> 6);
    LAS float* Ese = (LAS float*)lds;
    for (int it = vcu; it < 256; it += G) {
        const int g = it >> 2, b = (it >> 1) & 1, dir = it & 1, p = lane;
        const float ar = A16[((size_t)(dir * 64 + g) * 64 + p) * 2], ai = A16[((size_t)(dir * 64 + g) * 64 + p) * 2 + 1];
        const int c0 = dir == 0 ? wave * 64 : 511 - wave * 64;
        const unsigned* sp = (const unsigned*)(S + ((size_t)g * 1024 + b * 512 + c0) * 256 + dir * 128) + p;
        bf16_t* xp = AS + ((size_t)g * 1024 + b * 512 + c0) * 512 + 256 + dir * 128 + p;
        if (dir == 0) scan_item<1>(sp, xp, ar, ai, Ese, wave, p); else scan_item<-1>(sp, xp, ar, ai, Ese, wave, p);
    }
}

__device__ __forceinline__ void s5_fill_u(const float* xs, const float* SS, const float* gvec, const float* modp  , bf16_t* AS, int z, int pm, int tid) {
    const int sub = tid & 3, b = pm >> 1, col = 16 * z + 4 * sub;
    const f32x4 a4 = *(const f32x4*)(gvec + col) * (*(const f32x4*)(modp + (size_t)b * MODN + D + col) + 1.0f);
    const f32x4 s4 = *(const f32x4*)(modp + (size_t)b * MODN + col);
#pragma unroll 4
    for (int ps = 0; ps < 32; ++ps) {
        const int tok = 4096 * pm + ps * 128 + (tid >> 2);
        const float rs = pg8::rstd_from_ss(SS, tok);
        const f32x4 h = *(const f32x4*)(xs + (size_t)tok * D + col) * rs * a4 + s4;
        u32x2 w; w.x = pk2(h.x, h.y); w.y = pk2(h.z, h.w);
        *(u32x2*)(AS + ((size_t)z * 1024 + (tok >> 4)) * 512 + (tok & 15) * 16 + 4 * sub) = w;
    }
}

constexpr int LDS_BYTES = 147456;
__global__ void __launch_bounds__(NWAVES * 64, 2) fwd_kernel(Args args_unused) {
    extern __shared__ __attribute__((aligned(16))) unsigned char lds_raw[];
    LAS unsigned char* lds = (LAS unsigned char*)lds_raw;
    const CAS Args* ap0 = (const CAS Args*)__builtin_amdgcn_kernarg_segment_ptr();
    int ph_lo = ap0->ph_lo; const int ph_hi = ap0->ph_hi;
    volatile LAS unsigned* MISC = (volatile LAS unsigned*)(lds + 131072);
    if (threadIdx.x < 64) MISC[threadIdx.x] = 0u;
    __syncthreads();
    XcdBarrier bar; bar.bar = (unsigned*)(ap0->ws + WS_CTL) + CW_BAR; bar.x = 0; bar.st = nullptr;
    if (ap0->sync) bar = xcd_barrier_post((unsigned*)(ap0->ws + WS_CTL) + CW_BAR, MISC + 8);
#define GRID_SYNC() do { if (ap0->sync == 1) xcd_barrier(bar); else if (ap0->sync == 2) cg::this_grid().sync(); } while (0)
    if (ph_lo == 0) {
        const CAS Args* ap = ap0; asm volatile("" : "+s"(ap));
        int tid = threadIdx.x; asm volatile("" : "+v"(tid));
        const int G = gridDim.x, bx = blockIdx.x;
        const int vcu = (G % 8 == 0) ? (bx % 8) * (G / 8) + bx / 8 : bx;
        p0_prologue(ap, lds, vcu, G, tid);
        if (DUP_PH == 0) { GRID_SYNC(); p0_prologue(ap, lds, vcu, G, tid); }
        ph_lo = 1;
        if (ph_lo < ph_hi) GRID_SYNC();
    }
    for (int phx = ph_lo; phx < ph_hi + DUP_LEN; ++phx) {
        const int ph = (DUP_PH > 0 && phx > DUP_HI) ? phx - DUP_LEN : phx;
        const CAS Args* ap = ap0; asm volatile("" : "+s"(ap));
        int tid = threadIdx.x; asm volatile("" : "+v"(tid));
        const int G = gridDim.x, bx = blockIdx.x;
        const int vcu = (G % 8 == 0) ? (bx % 8) * (G / 8) + bx / 8 : bx;
        unsigned char* ws = ap->ws;
        float* MOD = (float*)(ws + WS_MOD);
        bf16_t* XN = (bf16_t*)(ws + WS_XN); bf16_t* ACT = (bf16_t*)(ws + WS_ACT); bf16_t* PP = ACT; bf16_t* AS = ACT;
        bf16_t* SB = (bf16_t*)(ws + WS_S); bf16_t* YB = (bf16_t*)(ws + WS_S + 32 * MiB);
        float* SS = (float*)(ws + WS_SS); float* SW = (float*)(ws + WS_SW);
        LAS float* PX = (LAS float*)(lds + 132096);
        float* xs = ap->out;
        switch (ph) {
        case 1: {
            norm_phase<3>(ap->in[0], ap->in[4], MOD, XN, SS, vcu, G, tid);
            sw_phase(MOD, (const bf16_t*)(ws + WS_WIN), SW, vcu, G, tid);
        } break;
        case 16: norm_phase<2>(xs, ap->in[20], nullptr, xs, nullptr, vcu, G, tid); break;
        case 2: case 6: case 8: case 14: {
            const int lf = ph == 2 ? 0 : ph == 6 ? 1 : ph == 8 ? 2 : 3;
            pg8::Gemm g{XN, (const bf16_t*)(ws + WS_WIN) + (size_t)lf * WIN_ELEMS, D, D, D, 0, 0, 0};
            pg8::StaticOrder S; S.init(M, NW1, G, bx);
            pg8::EpiSwiGLU E{ACT, FFP, SS, SW + (size_t)lf * 2 * NW1};
            pg8::gemm_phase<pg8::EpiSwiGLU, pg8::StaticOrder>(lds, g, S, E, tid);
        } break;
        case 3: case 7: case 9: case 15: case 5: {
            const bool pool = ph == 5;
            const int lf = ph == 3 ? 0 : ph == 7 ? 1 : ph == 9 ? 2 : 3, l = pool ? 0 : (lf >> 1), sub = pool ? 1 : (lf & 1) * 2;
            const int ln = sub == 2 ? l + 1 : l, sn = sub == 2 ? 0 : sub + 1, emit = (ph == 9 || ph == 15) ? 0 : 1, lnc = ln > 1 ? 1 : ln;
            const bf16_t* Ap = pool ? PP : ACT;
            const bf16_t* Bp = pool ? (const bf16_t*)(ws + WS_WPOOL) : (const bf16_t*)(ws + WS_WOUT) + (size_t)lf * WOUT_ELEMS;
            const int lda = pool ? D : FFP, ldb = pool ? 256 : FFP;
            pg8::Gemm g{Ap, Bp, lda, ldb, ldb, pool ? 256 : 0, 0, 0};
            const float* CZ = (const float*)(ws + WS_CONST);
            pg8::EpiResid E{ph == 3 ? ap->in[0] : xs, xs, MOD + (size_t)l * 2 * MODN + sub * 3 * D + 2 * D, pool ? ap->in[8] : CZ, pool ? ap->in[9] : CZ + D,
                            ap->in[4] + (lnc * 3 + sn) * D, MOD + (size_t)lnc * 2 * MODN + sn * 3 * D + D, XN, SS, PX, emit};
            pg8::StaticOrder S; S.init(M, D, G, bx);
            pg8::gemm_phase<pg8::EpiResid, pg8::StaticOrder>(lds, g, S, E, tid);
        } break;
        case 4: pool_phase(XN, SS, PP, vcu, G, tid); break;
        case 10: {
            pg8::Gemm g{AS, (const bf16_t*)(ws + WS_EBT), 512, 256, 256, 0, (size_t)1024 * 512, (size_t)256 * 256};
            pg8::GroupOrder S{256, G, bx};
            { pg8::Unit uu; for (int i = 0; S.next(i, uu); ++i) s5_fill_u(xs, SS, ap->in[4] + (1 * 3 + 1) * D, MOD + (size_t)2 * MODN + 3 * D, AS, uu.z, uu.pm, tid); }
            asm volatile("s_waitcnt vmcnt(0)" ::: "memory"); __syncthreads();
            pg8::EpiS16 E{SB};
            pg8::gemm_phase<pg8::EpiS16, pg8::GroupOrder>(lds, g, S, E, tid);
        } break;
        case 11: scan_phase(SB, (const float*)(ws + WS_A16), AS, lds, vcu, G, tid); break;
        case 12: {
            pg8::Gemm g{AS, (const bf16_t*)(ws + WS_TFBT), 512, 512, 512, 0, (size_t)1024 * 512, (size_t)256 * 512};
            pg8::GroupOrder S{256, G, bx};
            pg8::EpiS5Y E{YB};
            pg8::gemm_phase<pg8::EpiS5Y, pg8::GroupOrder>(lds, g, S, E, tid);
        } break;
        case 13: {
            pg8::Gemm g{YB, (const bf16_t*)(ws + WS_WGLU), D, D, D, 0, 0, 0};
            pg8::StaticOrder S; S.init(M, 2 * D, G, bx);
            pg8::EpiGLU E{xs, xs, MOD + (size_t)2 * MODN + 1 * 3 * D + 2 * D, ap->in[19], ap->in[4] + (1 * 3 + 2) * D, MOD + (size_t)2 * MODN + 2 * 3 * D + D, XN, SS, PX};
            pg8::gemm_phase<pg8::EpiGLU, pg8::StaticOrder>(lds, g, S, E, tid);
        } break;
        default: break;
        }
        if (phx + 1 < ph_hi + DUP_LEN) GRID_SYNC();
    }
}

extern "C" void kernel_launch(void* const* d_in, const int* in_sizes, int n_in, void* d_out, int out_size, void* d_ws, size_t ws_size, hipStream_t stream) {
    static int grid = 0;
    if (grid == 0) {
        if (n_in != 21 || in_sizes[0] != M * D || out_size != M * D || ws_size < WS_END) { fprintf(stderr, "kernel_launch: unexpected shapes (n_in %d, in0 %d, out %d, ws %zu < %zu)\n", n_in, n_in > 0 ? in_sizes[0] : -1, out_size, ws_size, (size_t)WS_END); grid = -1; return; }
        int dev = 0, cus = 0, per_cu = 0;
        if (hipGetDevice(&dev) != hipSuccess || hipDeviceGetAttribute(&cus, hipDeviceAttributeMultiprocessorCount, dev) != hipSuccess) { grid = -1; return; }
        if (hipFuncSetAttribute((const void*)fwd_kernel, hipFuncAttributeMaxDynamicSharedMemorySize, LDS_BYTES) != hipSuccess) { fprintf(stderr, "kernel_launch: hipFuncSetAttribute failed\n"); grid = -1; return; }
        if (hipOccupancyMaxActiveBlocksPerMultiprocessor(&per_cu, (const void*)fwd_kernel, NWAVES * 64, LDS_BYTES) != hipSuccess || per_cu < 1) { fprintf(stderr, "kernel_launch: occupancy query says %d\n", per_cu); per_cu = 1; }
        (void)hipGetLastError();
        grid = cus;
        if (grid > 256) grid = 256;
    }
    if (grid < 0) return;
    Args a{};
    for (int i = 0; i < 21; ++i) a.in[i] = (const float*)d_in[i];
    a.out = (float*)d_out; a.ws = (unsigned char*)d_ws;
#if ONE_LAUNCH
    if (hipMemsetAsync((char*)d_ws + WS_CTL, 0, CTL_ZERO_BYTES, stream) != hipSuccess) { fprintf(stderr, "kernel_launch: memset of the control words failed\n"); return; }
    a.ph_lo = 0; a.ph_hi = NPHASES; a.sync = 1; a.pad = 0;
    void* kargs[] = {&a};
    hipError_t e = hipLaunchCooperativeKernel((const void*)fwd_kernel, dim3(grid), dim3(NWAVES * 64), kargs, LDS_BYTES, stream);
    if (e != hipSuccess) fprintf(stderr, "kernel_launch: cooperative launch failed: %s (grid %d)\n", hipGetErrorString(e), grid);
#else
    for (int ph = 0; ph < NPHASES; ++ph) {
        a.ph_lo = ph; a.ph_hi = ph + 1; a.sync = 0; a.pad = 0;
        hipLaunchKernelGGL(fwd_kernel, dim3(grid), dim3(NWAVES * 64), LDS_BYTES, stream, a);
    }
#endif
}
```
